# Optimizing an MI355X kernel written in HIP

```python
import math
import jax, jax.numpy as jnp
from jax import lax
import numpy as np

D_MODEL = 1024
BATCH = 2
SEQ = 8192
DEPTH = 1
DEC_BATCH = 8
DEC_SEQ = 32
PAST_LEN = 1024

CHUNK = 64
N_RET_HEADS = 4
RET_DK = 256
RET_DV = 512
RET_QK_W = N_RET_HEADS * RET_DK
RET_V = N_RET_HEADS * RET_DV
CONV_W = 1024
CONV_K = 3
N_MEM = 256
N_MEM_HEADS = 4
MEM_HD = 256
MEM_W = N_MEM_HEADS * MEM_HD
D_FF = 2816
FFN_K = 3
N_BRANCH = 3
ROPE_BASE = 10000.0
EPS = 1e-6

IN_SPLITS = (
    RET_QK_W,
    2 * RET_QK_W,
    2 * RET_QK_W + RET_V,
    2 * RET_QK_W + 2 * RET_V,
    2 * RET_QK_W + 2 * RET_V + CONV_W,
    2 * RET_QK_W + 2 * RET_V + 2 * CONV_W,
    2 * RET_QK_W + 2 * RET_V + 3 * CONV_W,
    2 * RET_QK_W + 2 * RET_V + 3 * CONV_W + MEM_W,
)
IN_COLS = 2 * RET_QK_W + 2 * RET_V + 3 * CONV_W + MEM_W + N_BRANCH * D_MODEL

kernel_name = "hybrid_retention_shortconv_memory_encoder_step"


def rmsnorm(x, g):
    xf = x.astype(jnp.float32)
    r = lax.rsqrt(jnp.mean(xf * xf, axis=-1, keepdims=True) + EPS)
    return (xf * r).astype(x.dtype) * g


def rotary(x, pos):
    half = x.shape[-1] // 2
    inv = ROPE_BASE ** (-jnp.arange(half, dtype=jnp.float32) / half)
    ang = pos.astype(jnp.float32)[:, None] * inv[None, :]
    cos = jnp.cos(ang)[None, :, None, :]
    sin = jnp.sin(ang)[None, :, None, :]
    x1, x2 = x[..., :half], x[..., half:]
    return jnp.concatenate([x1 * cos - x2 * sin, x1 * sin + x2 * cos], axis=-1)


def ret_log_decay():
    return jnp.log(1.0 - 2.0 ** (-5.0 - jnp.arange(N_RET_HEADS, dtype=jnp.float32)))


def retention_block(q, k, v, s_prev, log_g):
    L = q.shape[2]
    idx = jnp.arange(L, dtype=jnp.float32)
    diff = idx[:, None] - idx[None, :]
    lg = log_g[:, None, None]
    dmask = jnp.where(diff >= 0, jnp.exp(lg * jnp.maximum(diff, 0.0)), 0.0)
    scores = jnp.einsum('bhld,bhmd->bhlm', q, k) * dmask
    intra = jnp.einsum('bhlm,bhme->bhle', scores, v)
    q_decay = jnp.exp(log_g[:, None] * (idx + 1.0)[None, :])
    cross = jnp.einsum('bhld,bhde->bhle', q * q_decay[..., None], s_prev)
    k_decay = jnp.exp(log_g[:, None] * (L - 1.0 - idx)[None, :])
    s_new = (jnp.exp(log_g * L)[:, None, None] * s_prev
             + jnp.einsum('bhld,bhle->bhde', k * k_decay[..., None], v))
    return intra + cross, s_new


def retention(q, k, v, s0):
    log_g = ret_log_decay()
    b, L = q.shape[0], q.shape[1]
    if L <= CHUNK:
        o, s = retention_block(q.transpose(0, 2, 1, 3), k.transpose(0, 2, 1, 3),
                               v.transpose(0, 2, 1, 3), s0, log_g)
        return o.transpose(0, 2, 1, 3), s
    n = L // CHUNK

    def to_chunks(t):
        return t.reshape(b, n, CHUNK, t.shape[2], t.shape[3]).transpose(1, 0, 3, 2, 4)

    def step(s, qkv):
        qc, kc, vc = qkv
        o, s = retention_block(qc, kc, vc, s, log_g)
        return s, o

    s, o = lax.scan(step, s0, (to_chunks(q), to_chunks(k), to_chunks(v)))
    o = o.transpose(1, 0, 3, 2, 4).reshape(b, L, N_RET_HEADS, RET_DV)
    return o, s


def head_groupnorm(o, g, dtype):
    mu = jnp.mean(o, axis=-1, keepdims=True)
    var = jnp.mean(jnp.square(o - mu), axis=-1, keepdims=True)
    on = (o - mu) * lax.rsqrt(var + EPS)
    return on.reshape(o.shape[0], o.shape[1], RET_V).astype(dtype) * g


def causal_dwconv(u, buf, w):
    kw = w.shape[0]
    L = u.shape[1]
    full = jnp.concatenate([buf.astype(u.dtype), u], axis=1)
    out = full[:, 0:L] * w[0]
    for j in range(1, kw):
        out = out + full[:, j:j + L] * w[j]
    return out, full[:, L:]


def memory_kv(mem, g_mem, w_mem_kv):
    m = rmsnorm(mem, g_mem)
    kv = m @ w_mem_kv
    b = mem.shape[0]
    k = kv[..., :MEM_W].reshape(b, N_MEM, N_MEM_HEADS, MEM_HD)
    v = kv[..., MEM_W:].reshape(b, N_MEM, N_MEM_HEADS, MEM_HD)
    return k, v


def memory_attend(q, mk, mv):
    s = jnp.einsum('blhd,bmhd->bhlm', q, mk).astype(jnp.float32) * (MEM_HD ** -0.5)
    p = jax.nn.softmax(s, axis=-1).astype(mv.dtype)
    o = jnp.einsum('bhlm,bmhd->blhd', p, mv)
    return o.reshape(q.shape[0], q.shape[1], MEM_W)


def layer(x, pos, s_ret, buf_conv, buf_ffn, mem_k, mem_v,
          g_mix, w_in, g_ret_gn, w_conv, w_br_ret, w_br_conv, w_br_mem, w_out,
          g_ffn, w_ffn_in, w_ffn_conv, w_ffn_down):
    b, L = x.shape[0], x.shape[1]
    h = rmsnorm(x, g_mix)
    z = h @ w_in
    q, k, v, gr, cb, cc, cx, mq, gates = jnp.split(z, IN_SPLITS, axis=-1)
    q = rotary(q.reshape(b, L, N_RET_HEADS, RET_DK).astype(jnp.float32), pos)
    k = rotary(k.reshape(b, L, N_RET_HEADS, RET_DK).astype(jnp.float32), pos) * (RET_DK ** -0.5)
    v = v.reshape(b, L, N_RET_HEADS, RET_DV).astype(jnp.float32)
    o_ret, s_new = retention(q, k, v, s_ret.astype(jnp.float32))
    o_ret = head_groupnorm(o_ret, g_ret_gn, x.dtype) * jax.nn.silu(gr)
    y_c, buf_conv_new = causal_dwconv(cc * cx, buf_conv, w_conv)
    o_conv = cb * y_c
    o_mem = memory_attend(mq.reshape(b, L, N_MEM_HEADS, MEM_HD), mem_k, mem_v)
    g = jax.nn.sigmoid(gates).reshape(b, L, N_BRANCH, D_MODEL)
    merged = (g[:, :, 0] * (o_ret @ w_br_ret)
              + g[:, :, 1] * (o_conv @ w_br_conv)
              + g[:, :, 2] * (o_mem @ w_br_mem))
    x = x + merged @ w_out
    h2 = rmsnorm(x, g_ffn)
    up = h2 @ w_ffn_in
    a, u = up[..., :D_FF], up[..., D_FF:]
    a_c, buf_ffn_new = causal_dwconv(a, buf_ffn, w_ffn_conv)
    x = x + (jax.nn.silu(a_c) * u) @ w_ffn_down
    return x, s_new.astype(x.dtype), buf_conv_new, buf_ffn_new


def setup_inputs(seed: int = 0) -> dict:
    key = jax.random.key(seed)
    ks = jax.random.split(key, 24)
    f32 = jnp.float32

    def nrm(k, shape, scale):
        return jax.random.normal(k, shape, f32) * scale

    def gain(k, shape):
        return 1.0 + 0.05 * jax.random.normal(k, shape, f32)

    return {
        "x_prompt": nrm(ks[0], (BATCH, SEQ, D_MODEL), 1.0),
        "x_sample": nrm(ks[1], (DEC_BATCH, DEC_SEQ, D_MODEL), 1.0),
        "mem_prompt": nrm(ks[2], (BATCH, N_MEM, D_MODEL), 1.0),
        "state_ret": nrm(ks[3], (DEPTH, DEC_BATCH, N_RET_HEADS, RET_DK, RET_DV), 1.0),
        "state_conv": nrm(ks[4], (DEPTH, DEC_BATCH, CONV_K - 1, CONV_W), 1.0),
        "state_ffn_conv": nrm(ks[5], (DEPTH, DEC_BATCH, FFN_K - 1, D_FF), 1.0),
        "cache_mem_k": nrm(ks[6], (DEPTH, DEC_BATCH, N_MEM, N_MEM_HEADS, MEM_HD), 1.0),
        "cache_mem_v": nrm(ks[7], (DEPTH, DEC_BATCH, N_MEM, N_MEM_HEADS, MEM_HD), 1.0),
        "g_mix": gain(ks[8], (DEPTH, D_MODEL)),
        "w_in": nrm(ks[9], (DEPTH, D_MODEL, IN_COLS), D_MODEL ** -0.5),
        "g_ret_gn": gain(ks[10], (DEPTH, RET_V)),
        "w_conv": nrm(ks[11], (DEPTH, CONV_K, CONV_W), CONV_K ** -0.5),
        "g_mem": gain(ks[12], (DEPTH, D_MODEL)),
        "w_mem_kv": nrm(ks[13], (DEPTH, D_MODEL, 2 * MEM_W), D_MODEL ** -0.5),
        "w_br_ret": nrm(ks[14], (DEPTH, RET_V, D_MODEL), RET_V ** -0.5),
        "w_br_conv": nrm(ks[15], (DEPTH, CONV_W, D_MODEL), CONV_W ** -0.5),
        "w_br_mem": nrm(ks[16], (DEPTH, MEM_W, D_MODEL), MEM_W ** -0.5),
        "w_out": nrm(ks[17], (DEPTH, D_MODEL, D_MODEL), D_MODEL ** -0.5),
        "g_ffn": gain(ks[18], (DEPTH, D_MODEL)),
        "w_ffn_in": nrm(ks[19], (DEPTH, D_MODEL, 2 * D_FF), D_MODEL ** -0.5),
        "w_ffn_conv": nrm(ks[20], (DEPTH, FFN_K, D_FF), FFN_K ** -0.5),
        "w_ffn_down": nrm(ks[21], (DEPTH, D_FF, D_MODEL), D_FF ** -0.5),
        "g_final": gain(ks[22], (D_MODEL,)),
    }


def reference(x_prompt, x_sample, mem_prompt, state_ret, state_conv, state_ffn_conv,
              cache_mem_k, cache_mem_v, g_mix, w_in, g_ret_gn, w_conv, g_mem, w_mem_kv,
              w_br_ret, w_br_conv, w_br_mem, w_out, g_ffn, w_ffn_in, w_ffn_conv, w_ffn_down,
              g_final):
    bp = x_prompt.shape[0]
    dt = x_prompt.dtype
    pos_p = jnp.arange(SEQ, dtype=jnp.int32)
    pos_s = PAST_LEN + jnp.arange(DEC_SEQ, dtype=jnp.int32)
    xp, xs = x_prompt, x_sample
    ret_p, conv_p, ffn_p, mk_p, mv_p = [], [], [], [], []
    ret_s, conv_s, ffn_s = [], [], []
    for l in range(DEPTH):
        lw = (g_mix[l], w_in[l], g_ret_gn[l], w_conv[l], w_br_ret[l], w_br_conv[l],
              w_br_mem[l], w_out[l], g_ffn[l], w_ffn_in[l], w_ffn_conv[l], w_ffn_down[l])
        mk, mv = memory_kv(mem_prompt, g_mem[l], w_mem_kv[l])
        s0 = jnp.zeros((bp, N_RET_HEADS, RET_DK, RET_DV), jnp.float32)
        b0c = jnp.zeros((bp, CONV_K - 1, CONV_W), dt)
        b0f = jnp.zeros((bp, FFN_K - 1, D_FF), dt)
        xp, sp, cp, fp = layer(xp, pos_p, s0, b0c, b0f, mk, mv, *lw)
        ret_p.append(sp); conv_p.append(cp); ffn_p.append(fp); mk_p.append(mk); mv_p.append(mv)
        xs, ss, cs, fs = layer(xs, pos_s, state_ret[l], state_conv[l], state_ffn_conv[l],
                               cache_mem_k[l], cache_mem_v[l], *lw)
        ret_s.append(ss); conv_s.append(cs); ffn_s.append(fs)
    y_prompt = rmsnorm(xp, g_final)
    y_sample = rmsnorm(xs, g_final)
    new_state_ret_prompt = jnp.stack(ret_p, 0)
    new_state_conv_prompt = jnp.stack(conv_p, 0)
    new_state_ffn_conv_prompt = jnp.stack(ffn_p, 0)
    new_cache_mem_k_prompt = jnp.stack(mk_p, 0)
    new_cache_mem_v_prompt = jnp.stack(mv_p, 0)
    new_state_ret_sample = jnp.stack(ret_s, 0)
    new_state_conv_sample = jnp.stack(conv_s, 0)
    new_state_ffn_conv_sample = jnp.stack(ffn_s, 0)
    return (y_prompt, y_sample, new_state_ret_prompt, new_state_conv_prompt,
            new_state_ffn_conv_prompt, new_cache_mem_k_prompt, new_cache_mem_v_prompt,
            new_state_ret_sample, new_state_conv_sample, new_state_ffn_conv_sample)
```

```cpp
#include <hip/hip_runtime.h>
#include <hip/hip_cooperative_groups.h>
#include <cstdio>
#include <cstdint>
namespace cg = cooperative_groups;
namespace pg8 {
#define PG8_LAS __attribute__((address_space(3)))
typedef unsigned short bf16_t;
typedef short bf16x8 __attribute__((ext_vector_type(8)));
typedef float f32x4 __attribute__((ext_vector_type(4)));
typedef unsigned u32x4 __attribute__((ext_vector_type(4)));
constexpr int BM = 256, BK = 64, HALF = 128, HTB = HALF * BK * 2  , STAGE_BYTES = 8 * HTB, NXCD = 8, WGM = 8;

__host__ __device__ __forceinline__ int lds_byte(int r, int c) { const int st = (r >> 4) * 2 + (c >> 5), rr = r & 15, cc = c & 31, ob = rr * 64 + cc * 2; return st * 1024 + (ob ^ (((ob >> 9) & 1) << 5)); }
__host__ __device__ __forceinline__ void stage_rc(int b, int& R, int& C) { const int st = b / 1024, sb = b % 1024, swz = sb ^ (((sb >> 9) & 1) << 5); R = (st >> 1) * 16 + swz / 64; C = (st & 1) * 32 + (swz % 64) / 2; }
__host__ __device__ __forceinline__ int perm32(int rho) { const int n = rho >> 4, i = rho & 15; return 8 * (i >> 2) + 4 * n + (i & 3); }

struct Unit { int pm, pn; };
struct Gemm { const bf16_t* A; const bf16_t* Bt; int M, N, K; };

struct StaticOrder {
    int nM, nN, nwg, G, c;
    __host__ __device__ __forceinline__ void init(int M, int N, int G_, int c_) { nM = M / BM; nN = N / BM; nwg = nM * nN; G = G_; c = c_; }
    __host__ __device__ __forceinline__ bool next(int i, Unit& u) const {
        const long L = (long)i * G + c; if (L >= nwg) return false;
        int wgid = (int)L; { const int q = nwg / NXCD, r = nwg % NXCD, xcd = wgid % NXCD, off = wgid / NXCD; wgid = (xcd < r ? xcd * (q + 1) : r * (q + 1) + (xcd - r) * q) + off; }
        const int nig = WGM * nN, gid = wgid / nig, fm = gid * WGM, gsz = (nM - fm) < WGM ? (nM - fm) : WGM;
        u.pm = fm + ((wgid % nig) % gsz); u.pn = (wgid % nig) / gsz; return true;
    }
    __device__ __forceinline__ void a_ready(const Unit&) const {}
    __device__ __forceinline__ void done(const Unit&) const {}
};
__device__ __forceinline__ unsigned cvt_pk_bf16(float lo, float hi) { unsigned r; asm volatile("v_cvt_pk_bf16_f32 %0, %1, %2" : "=v"(r) : "v"(lo), "v"(hi)); return r; }
template <class Epi, class Sched, bool ALIGN_EPI = false, bool SP2 = false>
__device__ __forceinline__ void gemm_phase(PG8_LAS unsigned char* lds, const Gemm g, const Sched& S, const Epi& E) {
    int tid_ = threadIdx.x; asm volatile("" : "+v"(tid_));
    const int tid = tid_, wid = __builtin_amdgcn_readfirstlane(tid >> 6), lane = tid & 63, wr = wid >> 2, wc = wid & 3, fr = lane & 15, fq = lane >> 4;
    const int K = g.K, nt = K / BK;
    unsigned voffA[2], voffB[2];
#pragma unroll
    for (int i = 0; i < 2; ++i) { int R, C; stage_rc(tid * 16 + i * 8192, R, C); const int Rb = Epi::PERM ? ((R & ~31) + perm32(R & 31)) : R;
        voffA[i] = (unsigned)(R * K + C) * 2u; voffB[i] = (unsigned)(Rb * K + C) * 2u; }
    const size_t kstep = (size_t)(BK * 2);
    const size_t hstep = (size_t)HALF * K * 2;
    const size_t tstep = 2 * hstep;
    const unsigned ldsw = (unsigned)wid * 1024u;
    const int aoff = lds_byte(wr * 64 + fr, fq * 8), boff = lds_byte(wc * 32 + fr, fq * 8);
#define PG8_SA(b, h) (((b) * 2 + (h)) * HTB)
#define PG8_SB(b, h) ((4 + (b) * 2 + (h)) * HTB)
#define PG8_STAGE(bufoff, gbase, voff) do { _Pragma("unroll") for (int _i = 0; _i < 2; ++_i) \
        __builtin_amdgcn_global_load_lds((const unsigned*)((const char*)(gbase) + (voff)[_i]), (PG8_LAS unsigned*)(lds + (bufoff) + ldsw + _i * 8192), 16, 0, 0); } while (0)
#define PG8_LDA(dst, b, h) do { _Pragma("unroll") for (int m = 0; m < 4; ++m) _Pragma("unroll") for (int k = 0; k < 2; ++k) dst[m][k] = *(const PG8_LAS bf16x8*)(lds + PG8_SA(b, h) + aoff + m * 2048 + k * 1024); } while (0)
#define PG8_LDB(dst, b, h) do { _Pragma("unroll") for (int n = 0; n < 2; ++n) _Pragma("unroll") for (int k = 0; k < 2; ++k) dst[n][k] = *(const PG8_LAS bf16x8*)(lds + PG8_SB(b, h) + boff + n * 2048 + k * 1024); } while (0)
#define PG8_MMA(ai, bj, At, Bt) do { __builtin_amdgcn_s_setprio(1); _Pragma("unroll") for (int m = 0; m < 4; ++m) _Pragma("unroll") for (int n = 0; n < 2; ++n) _Pragma("unroll") for (int k = 0; k < 2; ++k) \
        acc[ai][bj][m][n] = __builtin_amdgcn_mfma_f32_16x16x32_bf16(Bt[n][k], At[m][k], acc[ai][bj][m][n], 0, 0, 0); __builtin_amdgcn_s_setprio(0); } while (0)
#define PG8_WAIT_V(n) asm volatile("s_waitcnt vmcnt(" #n ")" ::: "memory")
#define PG8_WAIT_L(n) asm volatile("s_waitcnt lgkmcnt(" #n ")" ::: "memory")
#define PG8_BAR __builtin_amdgcn_s_barrier()
#define PG8_SCHED __builtin_amdgcn_sched_barrier(0)
    Unit cur, nxt; int ui = 0;
    if (!S.next(0, cur)) return;
    f32x4 acc[2][2][4][2];
#pragma unroll
    for (int a = 0; a < 2; ++a)
#pragma unroll
        for (int b = 0; b < 2; ++b)
#pragma unroll
            for (int m = 0; m < 4; ++m)
#pragma unroll
                for (int n = 0; n < 2; ++n) acc[a][b][m][n] = (f32x4){0.f, 0.f, 0.f, 0.f};
    bf16x8 At[4][2], B0[2][2], B1[2][2];
    const char* cA = (const char*)g.A + (size_t)cur.pm * tstep; const char* cB = (const char*)g.Bt + (size_t)cur.pn * tstep;
    S.a_ready(cur);
    if constexpr (SP2) {
        PG8_STAGE(PG8_SB(0, 0), cB, voffB); PG8_STAGE(PG8_SB(0, 1), cB + hstep, voffB); PG8_STAGE(PG8_SA(0, 0), cA, voffA); PG8_STAGE(PG8_SA(0, 1), cA + hstep, voffA);
        if (wr == 1) PG8_BAR;
        PG8_WAIT_V(2); PG8_BAR;
        PG8_STAGE(PG8_SB(1, 0), cB + kstep, voffB); PG8_STAGE(PG8_SA(1, 0), cA + kstep, voffA); PG8_STAGE(PG8_SB(1, 1), cB + hstep + kstep, voffB);
        PG8_WAIT_V(6); PG8_BAR;
    } else {
        PG8_STAGE(PG8_SB(0, 0), cB, voffB); PG8_STAGE(PG8_SA(0, 0), cA, voffA); PG8_STAGE(PG8_SB(0, 1), cB + hstep, voffB); PG8_STAGE(PG8_SA(0, 1), cA + hstep, voffA);
        if (wr == 1) PG8_BAR;
        PG8_WAIT_V(4); PG8_BAR;
        PG8_STAGE(PG8_SB(1, 0), cB + kstep, voffB); PG8_STAGE(PG8_SA(1, 0), cA + kstep, voffA); PG8_STAGE(PG8_SB(1, 1), cB + hstep + kstep, voffB);
        PG8_WAIT_V(6); PG8_BAR;
    }
    for (;;) {
        const bool has_next = S.next(ui + 1, nxt);
        const char* nA = has_next ? (const char*)g.A + (size_t)nxt.pm * tstep : cA; const char* nB = has_next ? (const char*)g.Bt + (size_t)nxt.pn * tstep : cB;
        for (int t = 0; t < nt; t += 2) {
            const bool last = (t == nt - 2);
            const char* a1 = cA + (size_t)(t + 1) * kstep;
            const char* a2 = last ? nA : cA + (size_t)(t + 2) * kstep; const char* b2 = last ? nB : cB + (size_t)(t + 2) * kstep;
            const char* a3 = a2 + kstep; const char* b3 = b2 + kstep;
            if (last && has_next) S.a_ready(nxt);
            if constexpr (SP2) {
            PG8_LDB(B0, 0, 0); PG8_LDB(B1, 0, 1); PG8_SCHED; PG8_LDA(At, 0, 0); PG8_STAGE(PG8_SA(1, 1), a1 + hstep, voffA);
            PG8_WAIT_V(8); PG8_WAIT_L(0); PG8_BAR; PG8_MMA(0, 0, At, B0); PG8_MMA(0, 1, At, B1); PG8_BAR; PG8_SCHED;
            PG8_LDA(At, 0, 1); PG8_STAGE(PG8_SB(0, 0), b2, voffB); PG8_STAGE(PG8_SB(0, 1), b2 + hstep, voffB); PG8_STAGE(PG8_SA(0, 0), a2, voffA);
            PG8_WAIT_V(8); PG8_WAIT_L(0); PG8_BAR; PG8_MMA(1, 0, At, B0); PG8_MMA(1, 1, At, B1); PG8_BAR; PG8_SCHED;
            PG8_LDB(B0, 1, 0); PG8_LDB(B1, 1, 1); PG8_SCHED; PG8_LDA(At, 1, 0); PG8_STAGE(PG8_SA(0, 1), a2 + hstep, voffA);
            PG8_WAIT_V(8); PG8_WAIT_L(0); PG8_BAR; PG8_MMA(0, 0, At, B0); PG8_MMA(0, 1, At, B1); PG8_BAR; PG8_SCHED;
            PG8_LDA(At, 1, 1); PG8_STAGE(PG8_SB(1, 0), b3, voffB); PG8_STAGE(PG8_SB(1, 1), b3 + hstep, voffB); PG8_STAGE(PG8_SA(1, 0), a3, voffA);
            PG8_WAIT_V(8); PG8_WAIT_L(0); PG8_BAR; PG8_MMA(1, 0, At, B0); PG8_MMA(1, 1, At, B1); PG8_BAR; PG8_SCHED;
            } else {
            PG8_LDB(B0, 0, 0); PG8_SCHED; PG8_LDA(At, 0, 0); PG8_STAGE(PG8_SA(1, 1), a1 + hstep, voffA);
            PG8_WAIT_L(8); PG8_BAR; PG8_WAIT_L(0); PG8_MMA(0, 0, At, B0); PG8_BAR; PG8_SCHED;
            PG8_LDB(B1, 0, 1); PG8_STAGE(PG8_SB(0, 0), b2, voffB);
            PG8_BAR; PG8_WAIT_L(0); PG8_MMA(0, 1, At, B1); PG8_BAR;
            PG8_LDA(At, 0, 1); PG8_STAGE(PG8_SA(0, 0), a2, voffA);
            PG8_BAR; PG8_WAIT_L(0); PG8_MMA(1, 0, At, B0); PG8_BAR; PG8_SCHED;
            PG8_STAGE(PG8_SB(0, 1), b2 + hstep, voffB);
            PG8_WAIT_V(6); PG8_BAR; PG8_MMA(1, 1, At, B1); PG8_BAR;
            PG8_LDB(B0, 1, 0); PG8_SCHED; PG8_LDA(At, 1, 0); PG8_STAGE(PG8_SA(0, 1), a2 + hstep, voffA);
            PG8_WAIT_L(8); PG8_BAR; PG8_WAIT_L(0); PG8_MMA(0, 0, At, B0); PG8_BAR; PG8_SCHED;
            PG8_LDB(B1, 1, 1); PG8_STAGE(PG8_SB(1, 0), b3, voffB);
            PG8_BAR; PG8_WAIT_L(0); PG8_MMA(0, 1, At, B1); PG8_BAR;
            PG8_LDA(At, 1, 1); PG8_STAGE(PG8_SA(1, 0), a3, voffA);
            PG8_BAR; PG8_WAIT_L(0); PG8_MMA(1, 0, At, B0); PG8_BAR; PG8_SCHED;
            PG8_STAGE(PG8_SB(1, 1), b3 + hstep, voffB);
            PG8_WAIT_V(6); PG8_BAR; PG8_MMA(1, 1, At, B1); PG8_BAR;
            }
        }
        if constexpr (ALIGN_EPI) { if (wr == 0) PG8_BAR; }
        if constexpr (!Epi::AFTER_DRAIN) { E(acc, cur, wr, wc, fr, fq); S.done(cur); }
        if (!has_next) break;
#pragma unroll
        for (int a = 0; a < 2; ++a)
#pragma unroll
            for (int b = 0; b < 2; ++b)
#pragma unroll
                for (int m = 0; m < 4; ++m)
#pragma unroll
                    for (int n = 0; n < 2; ++n) acc[a][b][m][n] = (f32x4){0.f, 0.f, 0.f, 0.f};
        cur = nxt; cA = nA; cB = nB; ++ui;
        if constexpr (ALIGN_EPI) { if (wr == 1) PG8_BAR; }
    }
    PG8_WAIT_V(0);
    if constexpr (!ALIGN_EPI) { if (wr == 0) PG8_BAR; }
    PG8_BAR;
    if constexpr (Epi::AFTER_DRAIN) { E.fused(acc, cur, wr, wc, fr, fq, lds, wid, lane); S.done(cur); }
#undef PG8_SA
#undef PG8_SB
#undef PG8_STAGE
#undef PG8_LDA
#undef PG8_LDB
#undef PG8_MMA
#undef PG8_WAIT_V
#undef PG8_WAIT_L
#undef PG8_BAR
#undef PG8_SCHED
}
}

using pg8::bf16_t; using pg8::f32x4; using pg8::bf16x8; using pg8::u32x4; using pg8::Unit;
#define LAS __attribute__((address_space(3)))
typedef unsigned u32x2 __attribute__((ext_vector_type(2)));
typedef short s16x4 __attribute__((ext_vector_type(4)));
typedef float f32x2_t __attribute__((ext_vector_type(2)));
typedef __bf16 bf16x2_t __attribute__((ext_vector_type(2)));

constexpr int TP = 16384, TSMP = 256, T = TP + TSMP, DM = 1024, DFF = 2816;
constexpr float EPS = 1e-6f;
constexpr size_t HMiB = 524288;
constexpr size_t WS_CTL = 0, CTL_BYTES = 2 * HMiB;
constexpr size_t WS_MKB = 2 * HMiB, WS_MVT = 12 * HMiB;
constexpr size_t WS_FFNIN = 2 * HMiB, WS_FFNDN = 24 * HMiB, WS_WOUT = 35 * HMiB, WS_BRRET = 39 * HMiB, WS_BRCONV = 47 * HMiB, WS_BRMEM = 51 * HMiB, WS_WIN = 55 * HMiB, WS_WMEMKV = 107 * HMiB;
constexpr size_t WS_HN = 115 * HMiB, WS_V = 180 * HMiB, WS_CB = 310 * HMiB, WS_P = 375 * HMiB, WS_MQ = 440 * HMiB, WS_END1 = 505 * HMiB;
constexpr size_t WS_MERGED = WS_P;
constexpr size_t WS_X1B = 39 * HMiB, WS_ABUF = 104 * HMiB, WS_UBUF = WS_ABUF + (size_t)T * DFF * 2, WS_END2 = WS_UBUF + (size_t)T * DFF * 2;
static_assert(WS_END2 <= 512 * HMiB && WS_END1 <= 512 * HMiB, "ws map");
constexpr size_t CTL_QUEUE = 0, CTL_SS1 = 4096, CTL_SS2 = 73728, CTL_STAT = 143360, CTL_FIN = 704512, CTL_XBAR = 720896;
static_assert(CTL_STAT + (size_t)T * 8 * 4 <= CTL_BYTES, "ctl");
constexpr size_t O_Y = 0, O_RETP = 17039360, O_CONVP = 18087936, O_FFNP = 18092032, O_MKP = 18103296, O_MVP = 18627584, O_RETS = 19151872, O_CONVS = 23346176, O_FFNS = 23362560, O_TOTAL = 23407616;
constexpr int LDS_BYTES = 147456, LDS_CTLOFF = LDS_BYTES - 128;

#ifndef REP_P0
#define REP_P0 1
#endif
#ifndef REP_P1
#define REP_P1 1
#endif
#ifndef REP_P3
#define REP_P3 1
#endif
#ifndef REP_P5
#define REP_P5 1
#endif
struct Args { const float* in[23]; float* out; unsigned char* ws; };

__device__ __forceinline__ unsigned pk2(float lo, float hi) { f32x2_t v = {lo, hi}; bf16x2_t b = __builtin_convertvector(v, bf16x2_t); return __builtin_bit_cast(unsigned, b); }
__device__ __forceinline__ float bflo(unsigned w) { return __builtin_bit_cast(float, w << 16); }
__device__ __forceinline__ float bfhi(unsigned w) { return __builtin_bit_cast(float, w & 0xffff0000u); }
__device__ __forceinline__ float sigm_f(float x) { return __builtin_amdgcn_rcpf(1.f + __expf(-x)); }
__device__ __forceinline__ float silu_f(float x) { return x * sigm_f(x); }
__device__ __forceinline__ f32x4 mfma16(bf16x8 a, bf16x8 b, f32x4 c) { return __builtin_amdgcn_mfma_f32_16x16x32_bf16(a, b, c, 0, 0, 0); }
__device__ __forceinline__ float wave_sum(float v) {
#pragma unroll
    for (int o = 1; o < 64; o <<= 1) v += __shfl_xor(v, o);
    return v;
}
__device__ __forceinline__ int tok_pos(int r) { return r < TP ? (r & 8191) : 1024 + ((r - TP) & 31); }
__device__ __forceinline__ bool tok_batch_start(int r) { return r < TP ? ((r & 8191) == 0) : (((r - TP) & 31) == 0); }

#define EPI_ARGS const f32x4 (&acc)[2][2][4][2], const Unit& u, int wr, int wc, int fr, int fq
__device__ __forceinline__ u32x4 pack8(const f32x4& a, const f32x4& b) { u32x4 w; w.x = pk2(a[0], a[1]); w.y = pk2(a[2], a[3]); w.z = pk2(b[0], b[1]); w.w = pk2(b[2], b[3]); return w; }

struct EpiZ1a {
    static constexpr bool PERM = true, AFTER_DRAIN = false;
    bf16_t *QK, *V, *CB, *P, *MQ;
    __device__ __forceinline__ void operator()(EPI_ARGS) const {
        const int row0 = u.pm * 256 + wr * 64 + fr, cl = wc * 32 + 8 * fq, pn = u.pn;
        if (pn < 8) {
            const float sc = pn >= 4 ? 0.0625f : 1.0f;
            float inv[8];
#pragma unroll
            for (int j = 0; j < 8; ++j) inv[j] = exp2f(-(float)(cl + j) * 0.10381025296523f) * 0.15915494309189535f;
#pragma unroll
            for (int ai = 0; ai < 2; ++ai)
#pragma unroll
                for (int m = 0; m < 4; ++m) {
                    const int r = row0 + ai * 128 + m * 16; const float pos = (float)tok_pos(r);
                    f32x4 o1[2], o2[2];
#pragma unroll
                    for (int n = 0; n < 2; ++n)
#pragma unroll
                        for (int i = 0; i < 4; ++i) {
                            float rev = pos * inv[4 * n + i]; rev -= floorf(rev);
                            const float s = __builtin_amdgcn_sinf(rev), c = __builtin_amdgcn_cosf(rev);
                            const float x1 = acc[ai][0][m][n][i], x2 = acc[ai][1][m][n][i];
                            o1[n][i] = (x1 * c - x2 * s) * sc; o2[n][i] = (x1 * s + x2 * c) * sc;
                        }
                    bf16_t* dst = QK + (size_t)pn * ((size_t)T * 256) + (size_t)r * 256 + cl;
                    *(u32x4*)dst = pack8(o1[0], o1[1]); *(u32x4*)(dst + 128) = pack8(o2[0], o2[1]);
                }
        } else if (pn < 20) {
            bf16_t* base; int ldc, c0;
            if (pn < 16) { base = V; ldc = 2048; c0 = (pn - 8) * 256; } else { base = CB; ldc = 1024; c0 = (pn - 16) * 256; }
#pragma unroll
            for (int ai = 0; ai < 2; ++ai)
#pragma unroll
                for (int m = 0; m < 4; ++m) {
                    bf16_t* dst = base + (size_t)(row0 + ai * 128 + m * 16) * ldc + c0 + cl;
#pragma unroll
                    for (int bj = 0; bj < 2; ++bj) *(u32x4*)(dst + bj * 128) = pack8(acc[ai][bj][m][0], acc[ai][bj][m][1]);
                }
        } else if (pn < 28) {
#pragma unroll
            for (int ai = 0; ai < 2; ++ai)
#pragma unroll
                for (int m = 0; m < 4; ++m) {
                    bf16_t* dst = P + (size_t)(row0 + ai * 128 + m * 16) * 1024 + (pn - 20) * 128 + cl;
                    *(u32x4*)dst = pack8(acc[ai][0][m][0] * acc[ai][1][m][0], acc[ai][0][m][1] * acc[ai][1][m][1]);
                }
        } else {
            const float sc = 0.0625f * 1.4426950408889634f;
#pragma unroll
            for (int ai = 0; ai < 2; ++ai)
#pragma unroll
                for (int m = 0; m < 4; ++m) {
                    bf16_t* dst = MQ + (size_t)(row0 + ai * 128 + m * 16) * 1024 + (pn - 28) * 256 + cl;
#pragma unroll
                    for (int bj = 0; bj < 2; ++bj) *(u32x4*)(dst + bj * 128) = pack8(acc[ai][bj][m][0] * sc, acc[ai][bj][m][1] * sc);
                }
        }
    }
};

struct EpiMemKV {
    static constexpr bool PERM = false, AFTER_DRAIN = false;
    float *outK, *outV; bf16_t *MKb, *MVt;
    __device__ __forceinline__ void operator()(EPI_ARGS) const {
        const int row0 = u.pm * 256 + wr * 64 + fr;
#pragma unroll
        for (int ai = 0; ai < 2; ++ai)
#pragma unroll
            for (int m = 0; m < 4; ++m) {
                const int r = row0 + ai * 128 + m * 16;
#pragma unroll
                for (int bj = 0; bj < 2; ++bj)
#pragma unroll
                    for (int n = 0; n < 2; ++n) {
                        const int c = u.pn * 256 + bj * 128 + wc * 32 + n * 16 + 4 * fq; const f32x4 v = acc[ai][bj][m][n];
                        if (u.pn < 4) { *(f32x4*)(outK + (size_t)r * 1024 + c) = v; u32x2 w; w.x = pk2(v[0], v[1]); w.y = pk2(v[2], v[3]); *(u32x2*)(MKb + (size_t)r * 1024 + c) = w; }
                        else {
                            const int cv = c - 1024; *(f32x4*)(outV + (size_t)r * 1024 + cv) = v;
                            const int b = r >> 8, mm = r & 255, pos = (mm & ~31) + 8 * ((mm >> 2) & 3) + 4 * ((mm >> 4) & 1) + (mm & 3);
#pragma unroll
                            for (int i = 0; i < 4; ++i) MVt[((size_t)b * 1024 + cv + i) * 256 + pos] = (bf16_t)(pk2(v[i], 0.f) & 0xffffu);
                        }
                    }
            }
    }
};

struct EpiGR {
    static constexpr bool PERM = true, AFTER_DRAIN = false;
    const bf16_t* O; bf16_t* ON; const float* stat; const float* ggn;
    __device__ __forceinline__ void operator()(EPI_ARGS) const {
        const int row0 = u.pm * 256 + wr * 64 + fr, cl = wc * 32 + 8 * fq, h = u.pn >> 1;
        f32x4 gv[2][2];
#pragma unroll
        for (int bj = 0; bj < 2; ++bj)
#pragma unroll
            for (int n = 0; n < 2; ++n) gv[bj][n] = *(const f32x4*)(ggn + u.pn * 256 + bj * 128 + cl + 4 * n);
#pragma unroll
        for (int ai = 0; ai < 2; ++ai) {
            u32x4 oq[4][2]; f32x2_t sq[4];
#pragma unroll
            for (int m = 0; m < 4; ++m) {
                const int r = row0 + ai * 128 + m * 16; sq[m] = *(const f32x2_t*)(stat + (size_t)r * 8 + 2 * h);
#pragma unroll
                for (int bj = 0; bj < 2; ++bj) oq[m][bj] = *(const u32x4*)(O + (size_t)r * 2048 + u.pn * 256 + bj * 128 + cl);
            }
            __builtin_amdgcn_sched_barrier(0);
#pragma unroll
            for (int m = 0; m < 4; ++m) {
                const int r = row0 + ai * 128 + m * 16;
                const float mu = sq[m].x * (1.f / 512.f), var = fmaxf(sq[m].y * (1.f / 512.f) - mu * mu, 0.f), rstd = rsqrtf(var + EPS);
#pragma unroll
                for (int bj = 0; bj < 2; ++bj) {
                    const size_t po = (size_t)r * 2048 + u.pn * 256 + bj * 128 + cl;
                    const u32x4 ov = oq[m][bj]; f32x4 o0, o1;
                    o0[0] = bflo(ov.x); o0[1] = bfhi(ov.x); o0[2] = bflo(ov.y); o0[3] = bfhi(ov.y); o1[0] = bflo(ov.z); o1[1] = bfhi(ov.z); o1[2] = bflo(ov.w); o1[3] = bfhi(ov.w);
                    f32x4 a0 = acc[ai][bj][m][0], a1 = acc[ai][bj][m][1];
#pragma unroll
                    for (int i = 0; i < 4; ++i) { a0[i] = (o0[i] - mu) * rstd * gv[bj][0][i] * silu_f(a0[i]); a1[i] = (o1[i] - mu) * rstd * gv[bj][1][i] * silu_f(a1[i]); }
                    *(u32x4*)(ON + po) = pack8(a0, a1);
                }
            }
        }
    }
};

struct EpiNull {
    static constexpr bool PERM = true, AFTER_DRAIN = false;
    const unsigned* flag; float* sink;
    __device__ __forceinline__ void operator()(EPI_ARGS) const {
        if (*flag == 12345u) {
#pragma unroll
            for (int ai = 0; ai < 2; ++ai)
#pragma unroll
                for (int m = 0; m < 4; ++m)
#pragma unroll
                    for (int bj = 0; bj < 2; ++bj) { sink[(u.pm * 256 + wr * 64 + fr + ai * 128 + m * 16) * 16 + wc + fq + bj] = acc[ai][bj][m][0][0] + acc[ai][bj][m][1][1]; }
        }
    }
};
struct EpiGate {
    static constexpr bool PERM = true, AFTER_DRAIN = false;
    bf16_t* S;
    __device__ __forceinline__ void operator()(EPI_ARGS) const {
        const int row0 = u.pm * 256 + wr * 64 + fr, cl = wc * 32 + 8 * fq;
#pragma unroll
        for (int ai = 0; ai < 2; ++ai)
#pragma unroll
            for (int m = 0; m < 4; ++m)
#pragma unroll
                for (int bj = 0; bj < 2; ++bj) {
                    f32x4 a0 = acc[ai][bj][m][0], a1 = acc[ai][bj][m][1];
#pragma unroll
                    for (int i = 0; i < 4; ++i) { a0[i] = sigm_f(a0[i]); a1[i] = sigm_f(a1[i]); }
                    *(u32x4*)(S + (size_t)(row0 + ai * 128 + m * 16) * 1024 + u.pn * 256 + bj * 128 + cl) = pack8(a0, a1);
                }
    }
};
template <bool FIRST> struct EpiBranch {
    static constexpr bool PERM = true, AFTER_DRAIN = false;
    const bf16_t* S; bf16_t* Mg;
    __device__ __forceinline__ void operator()(EPI_ARGS) const {
        const int row0 = u.pm * 256 + wr * 64 + fr, cl = wc * 32 + 8 * fq;
#pragma unroll
        for (int ai = 0; ai < 2; ++ai) {
            u32x4 gq[4][2], oq[4][2];
#pragma unroll
            for (int m = 0; m < 4; ++m)
#pragma unroll
                for (int bj = 0; bj < 2; ++bj) {
                    const size_t off = (size_t)(row0 + ai * 128 + m * 16) * 1024 + u.pn * 256 + bj * 128 + cl;
                    gq[m][bj] = *(const u32x4*)(S + off); if (!FIRST) oq[m][bj] = *(const u32x4*)(Mg + off);
                }
            __builtin_amdgcn_sched_barrier(0);
#pragma unroll
            for (int m = 0; m < 4; ++m)
#pragma unroll
                for (int bj = 0; bj < 2; ++bj) {
                    const size_t off = (size_t)(row0 + ai * 128 + m * 16) * 1024 + u.pn * 256 + bj * 128 + cl;
                    const u32x4 g = gq[m][bj];
                    f32x4 a0 = acc[ai][bj][m][0], a1 = acc[ai][bj][m][1];
                    a0[0] *= bflo(g.x); a0[1] *= bfhi(g.x); a0[2] *= bflo(g.y); a0[3] *= bfhi(g.y); a1[0] *= bflo(g.z); a1[1] *= bfhi(g.z); a1[2] *= bflo(g.w); a1[3] *= bfhi(g.w);
                    if (!FIRST) { const u32x4 o = oq[m][bj];
                        a0[0] += bflo(o.x); a0[1] += bfhi(o.x); a0[2] += bflo(o.y); a0[3] += bfhi(o.y); a1[0] += bflo(o.z); a1[1] += bfhi(o.z); a1[2] += bflo(o.w); a1[3] += bfhi(o.w); }
                    *(u32x4*)(Mg + off) = pack8(a0, a1);
                }
        }
    }
};

template <bool WITHB> struct EpiRes {
    static constexpr bool PERM = false, AFTER_DRAIN = false;
    const float* xp; const float* xs; float* xo; bf16_t* xb; float* ss;
    __device__ __forceinline__ void operator()(EPI_ARGS) const {
        const int row0 = u.pm * 256 + wr * 64 + fr;
#pragma unroll
        for (int ai = 0; ai < 2; ++ai) {
            f32x4 xv[4][2][2];
#pragma unroll
            for (int m = 0; m < 4; ++m) {
                const int r = row0 + ai * 128 + m * 16;
                const float* xin = r < TP ? xp + (size_t)r * 1024 : xs + (size_t)(r - TP) * 1024;
#pragma unroll
                for (int bj = 0; bj < 2; ++bj)
#pragma unroll
                    for (int n = 0; n < 2; ++n) xv[m][bj][n] = *(const f32x4*)(xin + u.pn * 256 + bj * 128 + wc * 32 + n * 16 + 4 * fq);
            }
            __builtin_amdgcn_sched_barrier(0);
#pragma unroll
            for (int m = 0; m < 4; ++m) {
                const int r = row0 + ai * 128 + m * 16;
                float q = 0.f;
#pragma unroll
                for (int bj = 0; bj < 2; ++bj)
#pragma unroll
                    for (int n = 0; n < 2; ++n) {
                        const int c = u.pn * 256 + bj * 128 + wc * 32 + n * 16 + 4 * fq;
                        const f32x4 v = xv[m][bj][n] + acc[ai][bj][m][n];
                        *(f32x4*)(xo + (size_t)r * 1024 + c) = v;
                        if (WITHB) { u32x2 w; w.x = pk2(v[0], v[1]); w.y = pk2(v[2], v[3]); *(u32x2*)(xb + (size_t)r * 1024 + c) = w; }
                        q += (v[0] * v[0] + v[1] * v[1]) + (v[2] * v[2] + v[3] * v[3]);
                    }
                q += __shfl_xor(q, 16); q += __shfl_xor(q, 32);
                if (fq == 0) atomicAdd(ss + r, q);
            }
        }
    }
};

__device__ __forceinline__ unsigned ld_agent(const unsigned* p) { return __hip_atomic_load(p, __ATOMIC_RELAXED, __HIP_MEMORY_SCOPE_AGENT); }
__device__ __forceinline__ float ld_agent_f(const float* p) { return __uint_as_float(__hip_atomic_load((const unsigned*)p, __ATOMIC_RELAXED, __HIP_MEMORY_SCOPE_AGENT)); }
__device__ __forceinline__ void panel_arrive_and_wait(unsigned* cnt, unsigned want) {
    asm volatile("s_waitcnt vmcnt(0)" ::: "memory");
    __syncthreads();
    if (threadIdx.x == 0) {
        __builtin_amdgcn_fence(__ATOMIC_RELEASE, "agent");
        asm volatile("s_waitcnt vmcnt(0)" ::: "memory");
        __hip_atomic_fetch_add(cnt, 1u, __ATOMIC_RELAXED, __HIP_MEMORY_SCOPE_AGENT);
        unsigned sp = 0;
        while (ld_agent(cnt) < want) { __builtin_amdgcn_s_sleep(2); if (++sp > (1u << 22)) break; }
        __builtin_amdgcn_fence(__ATOMIC_ACQUIRE, "agent");
    }
    __syncthreads();
}
struct EpiFinal {
    static constexpr bool PERM = false, AFTER_DRAIN = true;
    const float* x1; float* y; float* ss; unsigned* cnt; const float* gfin;
    __device__ __forceinline__ void operator()(EPI_ARGS) const {}
    __device__ __forceinline__ void fused(f32x4 (&acc)[2][2][4][2], const Unit& u, int wr, int wc, int fr, int fq, PG8_LAS unsigned char* lds, int wid, int lane) const {
        const int row0 = u.pm * 256 + wr * 64 + fr;
#pragma unroll
        for (int ai = 0; ai < 2; ++ai)
#pragma unroll
            for (int m = 0; m < 4; ++m) {
                const int r = row0 + ai * 128 + m * 16; float q = 0.f;
#pragma unroll
                for (int bj = 0; bj < 2; ++bj)
#pragma unroll
                    for (int n = 0; n < 2; ++n) {
                        const int c = u.pn * 256 + bj * 128 + wc * 32 + n * 16 + 4 * fq;
                        const f32x4 v = *(const f32x4*)(x1 + (size_t)r * 1024 + c) + acc[ai][bj][m][n];
                        acc[ai][bj][m][n] = v; q += (v[0] * v[0] + v[1] * v[1]) + (v[2] * v[2] + v[3] * v[3]);
                    }
                q += __shfl_xor(q, 16); q += __shfl_xor(q, 32);
                if (fq == 0) atomicAdd(ss + r, q);
            }
        panel_arrive_and_wait(cnt + 16 * u.pm, 4u);
#pragma unroll
        for (int ai = 0; ai < 2; ++ai)
#pragma unroll
            for (int m = 0; m < 4; ++m) {
                const int r = row0 + ai * 128 + m * 16; const float rs = rsqrtf(ld_agent_f(ss + r) * (1.f / 1024.f) + EPS);
#pragma unroll
                for (int bj = 0; bj < 2; ++bj)
#pragma unroll
                    for (int n = 0; n < 2; ++n) {
                        const int c = u.pn * 256 + bj * 128 + wc * 32 + n * 16 + 4 * fq;
                        *(f32x4*)(y + (size_t)r * 1024 + c) = acc[ai][bj][m][n] * rs * *(const f32x4*)(gfin + c);
                    }
            }
    }
};

struct EpiUp {
    static constexpr bool PERM = true, AFTER_DRAIN = false;
    bf16_t *A, *U; const float* ss; float *outP, *outS;
    __device__ __forceinline__ void operator()(EPI_ARGS) const {
        const int row0 = u.pm * 256 + wr * 64 + fr, ch = u.pn * 128 + wc * 32 + 8 * fq;
        float ssv[2][4];
#pragma unroll
        for (int ai = 0; ai < 2; ++ai)
#pragma unroll
            for (int m = 0; m < 4; ++m) ssv[ai][m] = ss[row0 + ai * 128 + m * 16];
        __builtin_amdgcn_sched_barrier(0);
#pragma unroll
        for (int ai = 0; ai < 2; ++ai)
#pragma unroll
            for (int m = 0; m < 4; ++m) {
                const int r = row0 + ai * 128 + m * 16; const float rs = rsqrtf(ssv[ai][m] * (1.f / 1024.f) + EPS);
                const f32x4 a0 = acc[ai][0][m][0] * rs, a1 = acc[ai][0][m][1] * rs;
                *(u32x4*)(A + (size_t)r * DFF + ch) = pack8(a0, a1);
                *(u32x4*)(U + (size_t)r * DFF + ch) = pack8(acc[ai][1][m][0] * rs, acc[ai][1][m][1] * rs);
                float* so = nullptr;
                if (r < TP) { const int t = r & 8191; if (t >= 8190) so = outP + ((size_t)(r >> 13) * 2 + (t - 8190)) * DFF; }
                else { const int t = (r - TP) & 31; if (t >= 30) so = outS + ((size_t)((r - TP) >> 5) * 2 + (t - 30)) * DFF; }
                if (so) { *(f32x4*)(so + ch) = a0; *(f32x4*)(so + ch + 4) = a1; }
            }
    }
};

template <bool PERMK>
__device__ __forceinline__ void transpose_item(const float* W, int N, bf16_t* WT, int ldt, int k0, int n0, int drow0, const float* kscale, LAS float* scr, int lane) {
    float tv[32];
#pragma unroll
    for (int i = 0; i < 32; ++i) tv[i] = W[(size_t)(k0 + 2 * i + (lane >> 5)) * N + n0 + (lane & 31)];
#pragma unroll
    for (int i = 0; i < 32; ++i) { const int kk = 2 * i + (lane >> 5); float v = tv[i]; if (kscale) v *= kscale[k0 + kk]; scr[kk * 33 + (lane & 31)] = v; }
    asm volatile("s_waitcnt lgkmcnt(0)" ::: "memory");
    const int c = lane & 7;
#pragma unroll
    for (int j = 0; j < 4; ++j) {
        const int n = (lane >> 3) + 8 * j; float e[8];
#pragma unroll
        for (int q = 0; q < 8; ++q) { const int kk = PERMK ? ((c >> 2) * 32 + 16 * (q >> 2) + 4 * (c & 3) + (q & 3)) : (8 * c + q); e[q] = scr[kk * 33 + n]; }
        u32x4 o; o.x = pk2(e[0], e[1]); o.y = pk2(e[2], e[3]); o.z = pk2(e[4], e[5]); o.w = pk2(e[6], e[7]);
        *(u32x4*)(WT + (size_t)(drow0 + n) * ldt + k0 + 8 * c) = o;
    }
    asm volatile("s_waitcnt lgkmcnt(0)" ::: "memory");
}
__device__ __forceinline__ int map_win(int n) {
    if (n < 4096) return n;
    if (n < 6144) return 8192 + (n - 4096);
    if (n < 7168) return 4096 + (n - 6144);
    if (n < 8192) { const int ch = n - 7168; return 5120 + (ch >> 7) * 256 + (ch & 127); }
    if (n < 9216) { const int ch = n - 8192; return 5120 + (ch >> 7) * 256 + 128 + (ch & 127); }
    if (n < 10240) return 7168 + (n - 9216);
    return n;
}
__device__ __forceinline__ int map_ffn(int c) { if (c < DFF) return (c >> 7) * 256 + (c & 127); c -= DFF; return (c >> 7) * 256 + 128 + (c & 127); }
__device__ __forceinline__ void row_norm_bf16(const float* xrow, const float* g, bf16_t* orow, int lane, bool norm) {
    f32x4 v[4]; float s = 0.f;
#pragma unroll
    for (int j = 0; j < 4; ++j) { v[j] = ((const f32x4*)xrow)[lane + 64 * j]; s += (v[j][0] * v[j][0] + v[j][1] * v[j][1]) + (v[j][2] * v[j][2] + v[j][3] * v[j][3]); }
    float rs = 1.f;
    if (norm) rs = rsqrtf(wave_sum(s) * (1.f / 1024.f) + EPS);
#pragma unroll
    for (int j = 0; j < 4; ++j) { f32x4 gg = norm ? ((const f32x4*)g)[lane + 64 * j] : (f32x4){1.f, 1.f, 1.f, 1.f}; u32x2 w; w.x = pk2(v[j][0] * rs * gg[0], v[j][1] * rs * gg[1]); w.y = pk2(v[j][2] * rs * gg[2], v[j][3] * rs * gg[3]); ((u32x2*)orow)[lane + 64 * j] = w; }
}

constexpr int SC_QS = 264, SC_KS = 272, SC_VS = 40, SC_SS = 40, SC_NCW = 2;
constexpr int SC_Q = 0, SC_K = 32 * SC_QS * 2, SC_V = SC_K + 32 * SC_KS * 2, SC_BUF = SC_V + 32 * SC_VS * 2, SC_S = 2 * SC_BUF, SC_SSZ = 32 * SC_SS * 2, SC_TOTAL = SC_S + 2 * SC_SSZ;
static_assert(SC_TOTAL <= 131072, "scan lds");
__device__ __forceinline__ s16x4 tr16(const LAS bf16_t* p) { typedef short v4i16 __attribute__((ext_vector_type(4))); return __builtin_bit_cast(s16x4, __builtin_amdgcn_ds_read_tr16_b64_v4i16((LAS v4i16*)p)); }
__device__ __forceinline__ bf16x8 cat8(s16x4 a, s16x4 b) { return (bf16x8){a[0], a[1], a[2], a[3], b[0], b[1], b[2], b[3]}; }

__device__ __forceinline__ void scan_scores(const LAS bf16_t* Qs, const LAS bf16_t* Ks, LAS bf16_t* Ss, int lane) {
    typedef float f32x16 __attribute__((ext_vector_type(16)));
    const int r32 = lane & 31, hh = lane >> 5;
    const LAS bf16_t* kp = Ks + r32 * SC_KS + 8 * hh; const LAS bf16_t* qp = Qs + r32 * SC_QS + 8 * hh;
    f32x16 sc = {0.f, 0.f, 0.f, 0.f, 0.f, 0.f, 0.f, 0.f, 0.f, 0.f, 0.f, 0.f, 0.f, 0.f, 0.f, 0.f};
#pragma unroll
    for (int half = 0; half < 2; ++half) {
        bf16x8 a[8], b[8];
#pragma unroll
        for (int s8 = 0; s8 < 8; ++s8) { a[s8] = *(const LAS bf16x8*)(kp + 16 * (8 * half + s8)); b[s8] = *(const LAS bf16x8*)(qp + 16 * (8 * half + s8)); }
#pragma unroll
        for (int s8 = 0; s8 < 8; ++s8) sc = __builtin_amdgcn_mfma_f32_32x32x16_bf16(a[s8], b[s8], sc, 0, 0, 0);
        __builtin_amdgcn_sched_barrier(0);
    }
#pragma unroll
    for (int q = 0; q < 4; ++q) {
        const int m0 = 8 * q + 4 * hh; float v[4];
#pragma unroll
        for (int i = 0; i < 4; ++i) v[i] = (m0 + i > r32) ? 0.f : sc[4 * q + i];
        u32x2 w; w.x = pk2(v[0], v[1]); w.y = pk2(v[2], v[3]);
        *(LAS u32x2*)(Ss + r32 * SC_SS + m0) = w;
    }
}
__device__ __forceinline__ void scan_scores16(const LAS bf16_t* Qs, const LAS bf16_t* Ks, LAS bf16_t* Ss, int lts, int mts, int g, int li) {
    f32x4 sc = {0.f, 0.f, 0.f, 0.f};
    const LAS bf16_t* kp = Ks + (16 * mts + li) * SC_KS + 8 * g; const LAS bf16_t* qp = Qs + (16 * lts + li) * SC_QS + 8 * g;
    bf16x8 a[8], b[8];
#pragma unroll
    for (int ks = 0; ks < 8; ++ks) { a[ks] = *(const LAS bf16x8*)(kp + 32 * ks); b[ks] = *(const LAS bf16x8*)(qp + 32 * ks); }
    f32x4 sc2 = {0.f, 0.f, 0.f, 0.f};
#pragma unroll
    for (int ks = 0; ks < 8; ks += 2) { sc = mfma16(a[ks], b[ks], sc); sc2 = mfma16(a[ks + 1], b[ks + 1], sc2); }
    sc = sc + sc2;
    const int l = 16 * lts + li;
#pragma unroll
    for (int i = 0; i < 4; ++i) if (16 * mts + 4 * g + i > l) sc[i] = 0.f;
    u32x2 w; w.x = pk2(sc[0], sc[1]); w.y = pk2(sc[2], sc[3]);
    *(LAS u32x2*)(Ss + l * SC_SS + 16 * mts + 4 * g) = w;
}
#define SCA_LDQ(F, kh) _Pragma("unroll") for (int k4 = 0; k4 < 4; ++k4) _Pragma("unroll") for (int l2 = 0; l2 < 2; ++l2) { \
        const LAS bf16_t* qp = Qs + (16 * l2 + li) * SC_QS + 32 * (4 * (kh) + k4) + 4 * g; F[2 * k4 + l2] = cat8(*(const LAS s16x4*)qp, *(const LAS s16x4*)(qp + 16)); }
__device__ __forceinline__ void scan_issue(bf16x8 (&F0)[8], bf16x8 (&F1)[8], bf16x8& vf, const LAS bf16_t* Qs, const LAS bf16_t* Vs, int wid, int g, int li) {
    const int q4 = li >> 2, p4 = li & 3;
    SCA_LDQ(F0, 0);
    vf = cat8(tr16(Vs + (4 * g + q4) * SC_VS + 16 * wid + 4 * p4), tr16(Vs + (16 + 4 * g + q4) * SC_VS + 16 * wid + 4 * p4));
    SCA_LDQ(F1, 1);
}
__device__ __forceinline__ void scan_main_a(f32x4 (&S)[16], f32x4 (&o)[2], bf16x8 (&F0)[8], bf16x8 (&F1)[8], const bf16x8 vf, const LAS bf16_t* Ks, int g, int li, float g32) {
    const int q4 = li >> 2, p4 = li & 3;
#define SCA_LDK(F, dh) _Pragma("unroll") for (int d8 = 0; d8 < 8; ++d8) { const int dt = 8 * (dh) + d8; \
        F[d8] = cat8(tr16(Ks + (4 * g + q4) * SC_KS + 16 * dt + 4 * p4), tr16(Ks + (16 + 4 * g + q4) * SC_KS + 16 * dt + 4 * p4)); }
#define SCA_CROSS(F, kh) _Pragma("unroll") for (int k4 = 0; k4 < 4; ++k4) { const int ks = 4 * (kh) + k4; \
        u32x4 aw; aw.x = pk2(S[2 * ks][0], S[2 * ks][1]); aw.y = pk2(S[2 * ks][2], S[2 * ks][3]); aw.z = pk2(S[2 * ks + 1][0], S[2 * ks + 1][1]); aw.w = pk2(S[2 * ks + 1][2], S[2 * ks + 1][3]); \
        const bf16x8 af = __builtin_bit_cast(bf16x8, aw); o[0] = mfma16(af, F[2 * k4], o[0]); o[1] = mfma16(af, F[2 * k4 + 1], o[1]); }
#define SCA_SUPD(F, dh) _Pragma("unroll") for (int d8 = 0; d8 < 8; ++d8) S[8 * (dh) + d8] = mfma16(F[d8], vf, S[8 * (dh) + d8]);
#pragma unroll
    for (int dt = 0; dt < 16; ++dt) S[dt] = S[dt] * g32;
    o[0] = (f32x4){0.f, 0.f, 0.f, 0.f}; o[1] = (f32x4){0.f, 0.f, 0.f, 0.f};
    __builtin_amdgcn_sched_barrier(0);
    SCA_CROSS(F0, 0);
    SCA_LDK(F0, 0);
    __builtin_amdgcn_sched_barrier(0);
    SCA_CROSS(F1, 1);
    SCA_LDK(F1, 1);
    __builtin_amdgcn_sched_barrier(0);
    SCA_SUPD(F0, 0);
    __builtin_amdgcn_sched_barrier(0);
    SCA_SUPD(F1, 1);
#undef SCA_LDK
#undef SCA_CROSS
#undef SCA_SUPD
}
#undef SCA_LDQ
__device__ __forceinline__ void scan_main_b(f32x4 (&o)[2], const bf16x8 vf, const LAS bf16_t* Ss, bf16_t* optr, const float (&fr)[2], int g, int li) {
#pragma unroll
    for (int l2 = 0; l2 < 2; ++l2) { const LAS bf16_t* sp_ = Ss + (16 * l2 + li) * SC_SS + 4 * g; const bf16x8 sb = cat8(*(const LAS s16x4*)sp_, *(const LAS s16x4*)(sp_ + 16)); o[l2] = mfma16(vf, sb, o[l2]); }
#pragma unroll
    for (int l2 = 0; l2 < 2; ++l2) {
        const f32x4 v = o[l2] * fr[l2];
        u32x2 w; w.x = pk2(v[0], v[1]); w.y = pk2(v[2], v[3]);
        *(u32x2*)(optr + (size_t)l2 * 16 * 2048) = w;
    }
}
struct ScanRegs { u32x4 q[4], k[4], v; };
__device__ __forceinline__ void scan_unit(LAS unsigned char* lds, const bf16_t* QK, bf16_t* Vb, float* stat, int row0, int nch, int h, int es, const float* S0, float* Sout, float log2g, int pmode = 0) {
    int tid_ = threadIdx.x; asm volatile("" : "+v"(tid_));
    const int tid = tid_, lane = tid & 63, wid = __builtin_amdgcn_readfirstlane(tid >> 6), g = lane >> 4, li = lane & 15;
    const bool loader = wid >= 4;
    const int lt = tid - 256;
    const int ecol = h * 512 + es * 32;
    const float g32 = exp2f(32.f * log2g);
#define SC_GLD(dst, ptr) asm volatile("global_load_dwordx4 %0, %1, off" : "=v"(dst) : "v"(ptr) : "memory")
#define SC_LOAD(c, R) do { const size_t rb = (size_t)(row0 + 32 * (c)); \
        _Pragma("unroll") for (int i = 0; i < 4; ++i) { const int id = lt + 256 * i, rr = id >> 5, cc = id & 31; const bf16_t* src = QK + (size_t)h * ((size_t)T * 256) + (rb + rr) * 256 + cc * 8; SC_GLD(R.q[i], src); SC_GLD(R.k[i], src + (size_t)4 * T * 256); } \
        { const int l2_ = lt & 127, rr = l2_ >> 2, cc = l2_ & 3; SC_GLD(R.v, Vb + (rb + rr) * 2048 + ecol + cc * 8); } } while (0)
#define SC_WAITV(n) asm volatile("s_waitcnt vmcnt(" #n ")" ::: "memory")
#define SC_SCALE(w, f) pk2(bflo(w) * (f), bfhi(w) * (f))
#define SC_WRITE(buf, R) do { LAS unsigned char* bb = lds + (buf) * SC_BUF; \
        _Pragma("unroll") for (int i = 0; i < 4; ++i) { const int id = lt + 256 * i, rr = id >> 5, cc = id & 31; \
            *(LAS u32x4*)(bb + SC_Q + (rr * SC_QS + cc * 8) * 2) = R.q[i]; *(LAS u32x4*)(bb + SC_K + (rr * SC_KS + cc * 8) * 2) = R.k[i]; } \
        if (lt < 128) { const int rr = lt >> 2, cc = lt & 3; const float vd = __builtin_amdgcn_exp2f((float)(31 - rr) * log2g); u32x4 vv; vv.x = SC_SCALE(R.v.x, vd); vv.y = SC_SCALE(R.v.y, vd); vv.z = SC_SCALE(R.v.z, vd); vv.w = SC_SCALE(R.v.w, vd); \
          *(LAS u32x4*)(bb + SC_V + (rr * SC_VS + cc * 8) * 2) = vv; } } while (0)
    LAS bf16_t* Ss = (LAS bf16_t*)(lds + SC_S);
    if (loader) {
        ScanRegs R0, R1, R2, R3;
        SC_LOAD(0, R0); SC_WAITV(0); __builtin_amdgcn_sched_barrier(0); SC_WRITE(0, R0);
        if (nch > 1) SC_LOAD(1, R1);
        if (nch > 2) SC_LOAD(2, R2);
        if (nch > 3) SC_LOAD(3, R3);
        __syncthreads();
#define SC_LSTEP(c, RFREE, RNEXT) do { if ((c) < nch) { if ((c) + 4 < nch && !(pmode & 2)) SC_LOAD((c) + 4, RFREE); \
            if (false) scan_scores((const LAS bf16_t*)(lds + ((c) & 1) * SC_BUF + SC_Q), (const LAS bf16_t*)(lds + ((c) & 1) * SC_BUF + SC_K), Ss, lane); \
            if ((c) + 4 < nch && !(pmode & 2)) SC_WAITV(27); else SC_WAITV(0); __builtin_amdgcn_sched_barrier(0); \
            if ((c) + 1 < nch && !(pmode & 2)) SC_WRITE(((c) + 1) & 1, RNEXT); __builtin_amdgcn_sched_barrier(0); __syncthreads(); } } while (0)
        for (int c = 0; c < nch; c += 4) { SC_LSTEP(c, R0, R1); SC_LSTEP(c + 1, R1, R2); SC_LSTEP(c + 2, R2, R3); SC_LSTEP(c + 3, R3, R0); }
#undef SC_LSTEP
    } else if (wid >= SC_NCW) {
        __syncthreads();
        for (int c = 0; c < nch; ++c) {
            const LAS bf16_t* Qs = (const LAS bf16_t*)(lds + (c & 1) * SC_BUF + SC_Q); const LAS bf16_t* Ks = (const LAS bf16_t*)(lds + (c & 1) * SC_BUF + SC_K);
            LAS bf16_t* Sc = (LAS bf16_t*)(lds + SC_S + (c & 1) * SC_SSZ);
            if (!(pmode & 4)) {
                if (wid == 2) { scan_scores16(Qs, Ks, Sc, 0, 0, g, li); scan_scores16(Qs, Ks, Sc, 1, 1, g, li); }
                else { scan_scores16(Qs, Ks, Sc, 1, 0, g, li); *(LAS u32x2*)(Sc + li * SC_SS + 16 + 4 * g) = (u32x2){0u, 0u}; }
            }
            __syncthreads();
        }
    } else {
        f32x4 S[16];
#pragma unroll
        for (int dt = 0; dt < 16; ++dt) S[dt] = (f32x4){0.f, 0.f, 0.f, 0.f};
        if (S0) {
            const float* sp = S0 + (size_t)(4 * g) * 512 + es * 32 + 16 * wid + li;
#pragma unroll
            for (int dt = 0; dt < 16; ++dt) {
#pragma unroll
                for (int i = 0; i < 4; ++i) S[dt][i] = sp[i * 512];
                sp += 16 * 512;
                if ((dt & 3) == 3) __builtin_amdgcn_sched_barrier(0);
            }
        }
        __syncthreads();
        float frow[2]; frow[0] = __builtin_amdgcn_exp2f((float)(li - 31) * log2g); frow[1] = __builtin_amdgcn_exp2f((float)(li - 15) * log2g);
        bf16_t* optr = Vb + (size_t)(row0 + li) * 2048 + ecol + 16 * wid + 4 * g;
        bf16x8 F0[8], F1[8], vfn;
        scan_issue(F0, F1, vfn, (const LAS bf16_t*)(lds + SC_Q), (const LAS bf16_t*)(lds + SC_V), wid, g, li);
        for (int c = 0; c < nch; ++c) {
            const int cur = c & 1;
            const LAS bf16_t* Ks = (const LAS bf16_t*)(lds + cur * SC_BUF + SC_K);
            f32x4 o[2]; const bf16x8 vf = vfn;
            if (!(pmode & 1)) scan_main_a(S, o, F0, F1, vf, Ks, g, li, g32);
            __syncthreads();
            __builtin_amdgcn_sched_barrier(0);
            if (c + 1 < nch) scan_issue(F0, F1, vfn, (const LAS bf16_t*)(lds + (cur ^ 1) * SC_BUF + SC_Q), (const LAS bf16_t*)(lds + (cur ^ 1) * SC_BUF + SC_V), wid, g, li);
            __builtin_amdgcn_sched_barrier(0);
            if (!(pmode & 1)) scan_main_b(o, vf, (const LAS bf16_t*)(lds + SC_S + (c & 1) * SC_SSZ), optr, frow, g, li);
            optr += (size_t)32 * 2048;
        }
        float* sp = Sout + (size_t)(4 * g) * 512 + es * 32 + 16 * wid + li;
#pragma unroll
        for (int dt = 0; dt < 16; ++dt) {
#pragma unroll
            for (int i = 0; i < 4; ++i) sp[i * 512] = S[dt][i];
            sp += 16 * 512;
            if ((dt & 3) == 3) __builtin_amdgcn_sched_barrier(0);
        }
    }
#undef SC_LOAD
#undef SC_GLD
#undef SC_WAITV
#undef SC_WRITE
#undef SC_SCALE
}

__device__ __forceinline__ void attn_wave(bf16_t* MQ, const bf16_t* Kb, const bf16_t* Vt, int t0, int h, int lane_) {
    int lane = lane_; asm volatile("" : "+v"(lane));
    const int g = lane >> 4, li = lane & 15;
    bf16x8 qf[8];
    bf16_t* qrow = MQ + (size_t)(t0 + li) * 1024 + h * 256;
#pragma unroll
    for (int ks = 0; ks < 8; ++ks) qf[ks] = *(const bf16x8*)(qrow + 32 * ks + 8 * g);
    f32x4 s[16];
#pragma unroll
    for (int mt = 0; mt < 16; ++mt) {
        s[mt] = (f32x4){0.f, 0.f, 0.f, 0.f};
        const bf16_t* kr = Kb + (size_t)(16 * mt + li) * 1024 + h * 256 + 8 * g;
#pragma unroll
        for (int ks = 0; ks < 8; ++ks) s[mt] = mfma16(*(const bf16x8*)(kr + 32 * ks), qf[ks], s[mt]);
    }
    float mx = -3.0e38f;
#pragma unroll
    for (int mt = 0; mt < 16; ++mt) mx = fmaxf(fmaxf(fmaxf(s[mt][0], s[mt][1]), fmaxf(s[mt][2], s[mt][3])), mx);
    mx = fmaxf(mx, __shfl_xor(mx, 16)); mx = fmaxf(mx, __shfl_xor(mx, 32));
    float sum = 0.f;
#pragma unroll
    for (int mt = 0; mt < 16; ++mt)
#pragma unroll
        for (int i = 0; i < 4; ++i) { const float p = __builtin_amdgcn_exp2f(s[mt][i] - mx); s[mt][i] = p; sum += p; }
    sum += __shfl_xor(sum, 16); sum += __shfl_xor(sum, 32);
    const float inv = 1.f / sum;
    bf16x8 pf[8];
#pragma unroll
    for (int k2 = 0; k2 < 8; ++k2) { u32x4 w; w.x = pk2(s[2 * k2][0], s[2 * k2][1]); w.y = pk2(s[2 * k2][2], s[2 * k2][3]); w.z = pk2(s[2 * k2 + 1][0], s[2 * k2 + 1][1]); w.w = pk2(s[2 * k2 + 1][2], s[2 * k2 + 1][3]); pf[k2] = __builtin_bit_cast(bf16x8, w); }
#pragma unroll 4
    for (int dt = 0; dt < 16; ++dt) {
        f32x4 o = {0.f, 0.f, 0.f, 0.f};
        const bf16_t* vr = Vt + (size_t)(h * 256 + 16 * dt + li) * 256 + 8 * g;
#pragma unroll
        for (int k2 = 0; k2 < 8; ++k2) o = mfma16(*(const bf16x8*)(vr + 32 * k2), pf[k2], o);
        o = o * inv; u32x2 w; w.x = pk2(o[0], o[1]); w.y = pk2(o[2], o[3]);
        *(u32x2*)(qrow + 16 * dt + 4 * g) = w;
    }
}

constexpr int AT_ST = 264;
static_assert(256 * AT_ST * 2 <= LDS_CTLOFF, "attention K/V tile fits below the LDS control words");
__device__ __forceinline__ void attn_unit_lds(LAS unsigned char* lds, bf16_t* MQ, const bf16_t* Kb, const bf16_t* Vt, int tblk, int h) {
    int tid_ = threadIdx.x; asm volatile("" : "+v"(tid_));
    const int tid = tid_, lane = tid & 63, wave = __builtin_amdgcn_readfirstlane(tid >> 6), g = lane >> 4, li = lane & 15;
    LAS bf16_t* T = (LAS bf16_t*)lds;
    u32x4 st[16];
#pragma unroll
    for (int i = 0; i < 16; ++i) { const int id = tid + 512 * i, row = id >> 5, cc = id & 31; st[i] = *(const u32x4*)(Kb + (size_t)row * 1024 + h * 256 + cc * 8); }
    bf16x8 qf[8];
    bf16_t* qrow = MQ + (size_t)(tblk + 16 * wave + li) * 1024 + h * 256;
#pragma unroll
    for (int ks = 0; ks < 8; ++ks) qf[ks] = *(const bf16x8*)(qrow + 32 * ks + 8 * g);
    __syncthreads();
#pragma unroll
    for (int i = 0; i < 16; ++i) { const int id = tid + 512 * i, row = id >> 5, cc = id & 31; *(LAS u32x4*)(T + row * AT_ST + cc * 8) = st[i]; }
#pragma unroll
    for (int i = 0; i < 16; ++i) { const int id = tid + 512 * i, row = id >> 5, cc = id & 31; st[i] = *(const u32x4*)(Vt + (size_t)(h * 256 + row) * 256 + cc * 8); }
    __syncthreads();
    f32x4 s[16];
#pragma unroll
    for (int mt = 0; mt < 16; ++mt) {
        s[mt] = (f32x4){0.f, 0.f, 0.f, 0.f};
        const LAS bf16_t* kr = T + (16 * mt + li) * AT_ST + 8 * g;
        bf16x8 kf[8];
#pragma unroll
        for (int ks = 0; ks < 8; ++ks) kf[ks] = *(const LAS bf16x8*)(kr + 32 * ks);
#pragma unroll
        for (int ks = 0; ks < 8; ++ks) s[mt] = mfma16(kf[ks], qf[ks], s[mt]);
    }
    float mx = -3.0e38f;
#pragma unroll
    for (int mt = 0; mt < 16; ++mt) mx = fmaxf(fmaxf(fmaxf(s[mt][0], s[mt][1]), fmaxf(s[mt][2], s[mt][3])), mx);
    mx = fmaxf(mx, __shfl_xor(mx, 16)); mx = fmaxf(mx, __shfl_xor(mx, 32));
    float sum = 0.f;
#pragma unroll
    for (int mt = 0; mt < 16; ++mt)
#pragma unroll
        for (int i = 0; i < 4; ++i) { const float p = __builtin_amdgcn_exp2f(s[mt][i] - mx); s[mt][i] = p; sum += p; }
    sum += __shfl_xor(sum, 16); sum += __shfl_xor(sum, 32);
    const float inv = 1.f / sum;
    bf16x8 pf[8];
#pragma unroll
    for (int k2 = 0; k2 < 8; ++k2) { u32x4 w; w.x = pk2(s[2 * k2][0], s[2 * k2][1]); w.y = pk2(s[2 * k2][2], s[2 * k2][3]); w.z = pk2(s[2 * k2 + 1][0], s[2 * k2 + 1][1]); w.w = pk2(s[2 * k2 + 1][2], s[2 * k2 + 1][3]); pf[k2] = __builtin_bit_cast(bf16x8, w); }
    __syncthreads();
#pragma unroll
    for (int i = 0; i < 16; ++i) { const int id = tid + 512 * i, row = id >> 5, cc = id & 31; *(LAS u32x4*)(T + row * AT_ST + cc * 8) = st[i]; }
    __syncthreads();
#pragma unroll 4
    for (int dt = 0; dt < 16; ++dt) {
        f32x4 o = {0.f, 0.f, 0.f, 0.f};
        const LAS bf16_t* vr = T + (16 * dt + li) * AT_ST + 8 * g;
        bf16x8 vf[8];
#pragma unroll
        for (int k2 = 0; k2 < 8; ++k2) vf[k2] = *(const LAS bf16x8*)(vr + 32 * k2);
#pragma unroll
        for (int k2 = 0; k2 < 8; ++k2) o = mfma16(vf[k2], pf[k2], o);
        o = o * inv; u32x2 w; w.x = pk2(o[0], o[1]); w.y = pk2(o[2], o[3]);
        *(u32x2*)(qrow + 16 * dt + 4 * g) = w;
    }
}

__device__ __forceinline__ void unpack8(const u32x4 w, float (&f)[8]) { f[0] = bflo(w.x); f[1] = bfhi(w.x); f[2] = bflo(w.y); f[3] = bfhi(w.y); f[4] = bflo(w.z); f[5] = bfhi(w.z); f[6] = bflo(w.w); f[7] = bfhi(w.w); }
__device__ __forceinline__ void load8f(const float* p, float (&f)[8]) { const f32x4 a = *(const f32x4*)p, b = *(const f32x4*)(p + 4); f[0] = a[0]; f[1] = a[1]; f[2] = a[2]; f[3] = a[3]; f[4] = b[0]; f[5] = b[1]; f[6] = b[2]; f[7] = b[3]; }
__device__ __forceinline__ void conv_item(int item, bf16_t* CB, const bf16_t* P, const float* wc, const float* st_s, float* outP, float* outS) {
    const int rg = item >> 7, c = (item & 127) * 8, r0 = rg * 8;
    float w0[8], w1[8], w2[8], h2[8], h1[8];
    load8f(wc + c, w0); load8f(wc + 1024 + c, w1); load8f(wc + 2048 + c, w2);
    if (tok_batch_start(r0)) {
        if (r0 < TP) {
#pragma unroll
            for (int k = 0; k < 8; ++k) { h2[k] = 0.f; h1[k] = 0.f; }
        } else { const float* sp = st_s + (size_t)((r0 - TP) >> 5) * 2048 + c; load8f(sp, h2); load8f(sp + 1024, h1); }
    } else { unpack8(*(const u32x4*)(P + (size_t)(r0 - 2) * 1024 + c), h2); unpack8(*(const u32x4*)(P + (size_t)(r0 - 1) * 1024 + c), h1); }
    u32x4 pw[8], bw[8];
#pragma unroll
    for (int i = 0; i < 8; ++i) { pw[i] = *(const u32x4*)(P + (size_t)(r0 + i) * 1024 + c); bw[i] = *(const u32x4*)(CB + (size_t)(r0 + i) * 1024 + c); }
#pragma unroll
    for (int i = 0; i < 8; ++i) {
        const int r = r0 + i; float p[8], b[8], y[8];
        unpack8(pw[i], p); unpack8(bw[i], b);
#pragma unroll
        for (int k = 0; k < 8; ++k) y[k] = b[k] * (w0[k] * h2[k] + w1[k] * h1[k] + w2[k] * p[k]);
        u32x4 o; o.x = pk2(y[0], y[1]); o.y = pk2(y[2], y[3]); o.z = pk2(y[4], y[5]); o.w = pk2(y[6], y[7]);
        *(u32x4*)(CB + (size_t)r * 1024 + c) = o;
        float* so = nullptr;
        if (r < TP) { const int t = r & 8191; if (t >= 8190) so = outP + ((size_t)(r >> 13) * 2 + (t - 8190)) * 1024; }
        else { const int t = (r - TP) & 31; if (t >= 30) so = outS + ((size_t)((r - TP) >> 5) * 2 + (t - 30)) * 1024; }
        if (so) { *(f32x4*)(so + c) = (f32x4){p[0], p[1], p[2], p[3]}; *(f32x4*)(so + c + 4) = (f32x4){p[4], p[5], p[6], p[7]}; }
#pragma unroll
        for (int k = 0; k < 8; ++k) { h2[k] = h1[k]; h1[k] = p[k]; }
    }
}
__device__ __forceinline__ void act_item(int item, const bf16_t* A, bf16_t* U, const float* wc, const float* st_s, bool do_store = true) {
    const int rg = item / 352, c = (item - rg * 352) * 8, r0 = rg * 8;
    float w0[8], w1[8], w2[8], h2[8], h1[8];
    load8f(wc + c, w0); load8f(wc + DFF + c, w1); load8f(wc + 2 * DFF + c, w2);
    if (tok_batch_start(r0)) {
        if (r0 < TP) {
#pragma unroll
            for (int k = 0; k < 8; ++k) { h2[k] = 0.f; h1[k] = 0.f; }
        } else { const float* sp = st_s + (size_t)((r0 - TP) >> 5) * 2 * DFF + c; load8f(sp, h2); load8f(sp + DFF, h1); }
    } else { unpack8(*(const u32x4*)(A + (size_t)(r0 - 2) * DFF + c), h2); unpack8(*(const u32x4*)(A + (size_t)(r0 - 1) * DFF + c), h1); }
    u32x4 aw[8], uw[8];
#pragma unroll
    for (int i = 0; i < 8; ++i) { aw[i] = *(const u32x4*)(A + (size_t)(r0 + i) * DFF + c); uw[i] = *(const u32x4*)(U + (size_t)(r0 + i) * DFF + c); }
#pragma unroll
    for (int i = 0; i < 8; ++i) {
        float a[8], u[8], y[8];
        unpack8(aw[i], a); unpack8(uw[i], u);
#pragma unroll
        for (int k = 0; k < 8; ++k) y[k] = silu_f(w0[k] * h2[k] + w1[k] * h1[k] + w2[k] * a[k]) * u[k];
        u32x4 o; o.x = pk2(y[0], y[1]); o.y = pk2(y[2], y[3]); o.z = pk2(y[4], y[5]); o.w = pk2(y[6], y[7]);
        if (do_store) *(u32x4*)(U + (size_t)(r0 + i) * DFF + c) = o;
#pragma unroll
        for (int k = 0; k < 8; ++k) { h2[k] = h1[k]; h1[k] = a[k]; }
    }
}

__device__ __forceinline__ f32x4 skinny_gemm(LAS unsigned char* lds, const bf16_t* Act, int K, const bf16_t* Wt, int n0, int rq, int wave, int lane_) {
    int lane = lane_; asm volatile("" : "+v"(lane));
    const int g = lane >> 4, li = lane & 15, K8 = K >> 3, nk = K8 >> 5;
    const bf16_t* wp = Wt + (size_t)(n0 + li) * K + wave * K8 + 8 * g;
    const bf16_t* ap = Act + (size_t)(64 * rq + li) * K + wave * K8 + 8 * g;
    f32x4 acc[4];
#pragma unroll
    for (int t = 0; t < 4; ++t) acc[t] = (f32x4){0.f, 0.f, 0.f, 0.f};
    for (int k0 = 0; k0 < nk; k0 += 4) {
        bf16x8 wf[4], xf[4][4];
#pragma unroll
        for (int j = 0; j < 4; ++j) if (k0 + j < nk) {
            wf[j] = *(const bf16x8*)(wp + 32 * (k0 + j));
#pragma unroll
            for (int t = 0; t < 4; ++t) xf[j][t] = *(const bf16x8*)(ap + (size_t)(16 * t) * K + 32 * (k0 + j));
        }
#pragma unroll
        for (int j = 0; j < 4; ++j) if (k0 + j < nk) {
#pragma unroll
            for (int t = 0; t < 4; ++t) acc[t] = mfma16(wf[j], xf[j][t], acc[t]);
        }
    }
    LAS f32x4* xch = (LAS f32x4*)(lds + 65536);
    __syncthreads();
#pragma unroll
    for (int t = 0; t < 4; ++t) xch[(wave * 4 + t) * 64 + lane] = acc[t];
    __syncthreads();
    f32x4 r = {0.f, 0.f, 0.f, 0.f};
    if (wave < 4) {
#pragma unroll
        for (int w = 0; w < 8; ++w) r = r + xch[(w * 4 + wave) * 64 + lane];
    }
    return r;
}
#define XB_TMO      128
#define XB_XCNT(j)  (256  + 64 * (j))
#define XB_XSUB(j)  (1280 + 64 * (j))
#define XB_XGEN(j)  (2304 + 64 * (j))
#define XB_TOP      3328
#define XB_TOPGEN   3392
#define XCD_BAR_WORDS 3456
#define XB_SPIN_CAP (1u << 18)

__device__ __forceinline__ unsigned xb_ld(unsigned* p)              { return __hip_atomic_load(p, __ATOMIC_RELAXED, __HIP_MEMORY_SCOPE_AGENT); }
__device__ __forceinline__ unsigned xb_add(unsigned* p, unsigned v) { return __hip_atomic_fetch_add(p, v, __ATOMIC_RELAXED, __HIP_MEMORY_SCOPE_AGENT); }
__device__ __forceinline__ unsigned xb_xcc_id() { return (unsigned)__builtin_amdgcn_s_getreg((3 << 11) | 20) & 0xFu; }
#define XB_SPIN(cond, bar) do { unsigned _sp = 0; while (cond) { __builtin_amdgcn_s_sleep(1); \
    if ((++_sp & 255u) == 0u) { if (xb_ld(&(bar)[XB_TMO])) break; if (_sp > XB_SPIN_CAP) { atomicAdd(&(bar)[XB_TMO], 1u); break; } } } } while (0)

struct XcdBarrier {
    unsigned* bar; unsigned x;
    volatile __attribute__((address_space(3))) unsigned* st;
};

__device__ __forceinline__ XcdBarrier xcd_barrier_post(unsigned* bar, volatile __attribute__((address_space(3))) unsigned* st) {
    XcdBarrier b; b.bar = bar; b.x = xb_xcc_id(); b.st = st;
    if (threadIdx.x == 0) (void)xb_add(&bar[XB_XCNT(b.x)], 1u);
    return b;
}
__device__ __forceinline__ void xcd_barrier_complete(unsigned* bar, unsigned x, unsigned& nloc, unsigned& nx) {
    const unsigned G = gridDim.x * gridDim.y * gridDim.z;
    unsigned sum, cnt, mine, sp = 0u;
    for (;;) {
        sum = 0u; cnt = 0u; mine = 0u;
#pragma unroll
        for (unsigned j = 0; j < 16; ++j) { const unsigned c = xb_ld(&bar[XB_XCNT(j)]); sum += c; cnt += (c > 0u) ? 1u : 0u; mine = (j == x) ? c : mine; }
        if (sum == G) break;
        __builtin_amdgcn_s_sleep(1);
        if ((++sp & 255u) == 0u) { if (xb_ld(&bar[XB_TMO])) break; if (sp > XB_SPIN_CAP) { atomicAdd(&bar[XB_TMO], 1u); break; } }
    }
    nloc = mine > 0u ? mine : 1u; nx = cnt > 0u ? cnt : 1u;
}

__device__ __forceinline__ void xcd_barrier(const XcdBarrier& b) {
    asm volatile("s_waitcnt vmcnt(0)" ::: "memory");
    __syncthreads();
    if (threadIdx.x == 0) {
        unsigned* bar = b.bar;
        __builtin_amdgcn_s_waitcnt(0);
        unsigned nloc = b.st[0], nx = b.st[1];
        if (nloc == 0u) { xcd_barrier_complete(bar, b.x, nloc, nx); b.st[0] = nloc; b.st[1] = nx; }
        const unsigned old = xb_add(&bar[XB_XSUB(b.x)], 1u);
        const unsigned gen = old / nloc;
        if (old + 1u == (gen + 1u) * nloc) {
            __builtin_amdgcn_fence(__ATOMIC_RELEASE, "agent");
            asm volatile("s_waitcnt vmcnt(0)" ::: "memory");
            const unsigned og = xb_add(&bar[XB_TOP], 1u);
            const unsigned tg = og / nx;
            if (og + 1u == (tg + 1u) * nx) xb_add(&bar[XB_TOPGEN], 1u);
            else XB_SPIN(xb_ld(&bar[XB_TOPGEN]) == tg, bar);
            __builtin_amdgcn_fence(__ATOMIC_ACQUIRE, "agent");
            xb_add(&bar[XB_XGEN(b.x)], 1u);
            asm volatile("s_waitcnt vmcnt(0)" ::: "memory");
        } else {
            XB_SPIN(xb_ld(&bar[XB_XGEN(b.x)]) == gen, bar);
            __builtin_amdgcn_fence(__ATOMIC_ACQUIRE, "agent");
            asm volatile("s_waitcnt vmcnt(0)" ::: "memory");
        }
    }
    __syncthreads();
}

__global__ void __launch_bounds__(512, 2) fwd_megakernel(Args args) {
    extern __shared__ __attribute__((aligned(16))) unsigned char lds_raw[];
    LAS unsigned char* lds = (LAS unsigned char*)lds_raw;
    cg::grid_group grid = cg::this_grid();
    { volatile LAS unsigned* z = (volatile LAS unsigned*)(lds + LDS_CTLOFF); if (threadIdx.x < 16) z[threadIdx.x] = 0u; __syncthreads(); }
    if (args.out == nullptr) grid.sync();
    const XcdBarrier xbar = xcd_barrier_post((unsigned*)(args.ws + WS_CTL + CTL_XBAR), (volatile LAS unsigned*)(lds + LDS_CTLOFF + 16));
    const int G = gridDim.x, blk = blockIdx.x, NGW = G * 8;
#define PHASE_IDS() int tid_ = threadIdx.x; asm volatile("" : "+v"(tid_)); const int tid = tid_, lane = tid & 63, wave = __builtin_amdgcn_readfirstlane(tid >> 6), gw = blk * 8 + wave; (void)gw; (void)lane; (void)tid
    unsigned char* ws = args.ws; float* out = args.out;
    const float* x_prompt = args.in[0]; const float* x_sample = args.in[1]; const float* mem_prompt = args.in[2]; const float* state_ret = args.in[3];
    const float* state_conv = args.in[4]; const float* state_ffn = args.in[5]; const float* cache_k = args.in[6]; const float* cache_v = args.in[7];
    const float* g_mix = args.in[8]; const float* w_in = args.in[9]; const float* g_ret_gn = args.in[10]; const float* w_conv = args.in[11]; const float* g_mem = args.in[12];
    const float* w_mem_kv = args.in[13]; const float* w_br_ret = args.in[14]; const float* w_br_conv = args.in[15]; const float* w_br_mem = args.in[16]; const float* w_out = args.in[17];
    const float* g_ffn = args.in[18]; const float* w_ffn_in = args.in[19]; const float* w_ffn_conv = args.in[20]; const float* w_ffn_down = args.in[21]; const float* g_final = args.in[22];
    bf16_t* FFNIN = (bf16_t*)(ws + WS_FFNIN); bf16_t* FFNDN = (bf16_t*)(ws + WS_FFNDN); bf16_t* WOUT = (bf16_t*)(ws + WS_WOUT); bf16_t* BRRET = (bf16_t*)(ws + WS_BRRET);
    bf16_t* BRCONV = (bf16_t*)(ws + WS_BRCONV); bf16_t* BRMEM = (bf16_t*)(ws + WS_BRMEM); bf16_t* WIN = (bf16_t*)(ws + WS_WIN); bf16_t* WMEMKV = (bf16_t*)(ws + WS_WMEMKV);
    bf16_t* HN = (bf16_t*)(ws + WS_HN); bf16_t* Vb = (bf16_t*)(ws + WS_V); bf16_t* CB = (bf16_t*)(ws + WS_CB); bf16_t* Pb = (bf16_t*)(ws + WS_P); bf16_t* MQ = (bf16_t*)(ws + WS_MQ);
    bf16_t* MKB = (bf16_t*)(ws + WS_MKB); bf16_t* MVT = (bf16_t*)(ws + WS_MVT); bf16_t* MERGED = (bf16_t*)(ws + WS_MERGED);
    bf16_t* X1B = (bf16_t*)(ws + WS_X1B); bf16_t* ABUF = (bf16_t*)(ws + WS_ABUF); bf16_t* UBUF = (bf16_t*)(ws + WS_UBUF);
    unsigned* queue = (unsigned*)(ws + WS_CTL + CTL_QUEUE); float* SS1 = (float*)(ws + WS_CTL + CTL_SS1); float* SS2 = (float*)(ws + WS_CTL + CTL_SS2); float* STAT = (float*)(ws + WS_CTL + CTL_STAT);
    bf16_t* QK = (bf16_t*)out;
    bf16_t* ORNB = (bf16_t*)out; bf16_t* STASH = Vb; float* X1 = out + O_Y;
    bf16_t* MEMN = (bf16_t*)(out + O_RETS);

    for (int rep_ = 0; rep_ < REP_P0; ++rep_)
    {
        PHASE_IDS(); LAS float* scr = (LAS float*)(lds + wave * 16384);
        constexpr int I_WIN = 16 * 416, I_MKV = 16 * 64, I_RET = 32 * 32, I_SQ = 16 * 32, I_CV = 8 * 4 * 32;
        constexpr int NIT = I_WIN + I_MKV + I_RET + 3 * I_SQ + I_CV;
        for (int it = gw; it < NIT; it += NGW) {
            int r = it;
            if (r < I_WIN) { const int kb = r / 416, nb = r % 416; transpose_item<false>(w_in, 13312, WIN, 1024, 64 * kb, 32 * nb, map_win(32 * nb), nullptr, scr, lane); continue; } r -= I_WIN;
            if (r < I_MKV) { const int kb = r / 64, nb = r % 64; transpose_item<false>(w_mem_kv, 2048, WMEMKV, 1024, 64 * kb, 32 * nb, 32 * nb, nullptr, scr, lane); continue; } r -= I_MKV;
            if (r < I_RET) { const int kb = r / 32, nb = r % 32; transpose_item<false>(w_br_ret, 1024, BRRET, 2048, 64 * kb, 32 * nb, 32 * nb, nullptr, scr, lane); continue; } r -= I_RET;
            if (r < I_SQ) { const int kb = r / 32, nb = r % 32; transpose_item<false>(w_br_conv, 1024, BRCONV, 1024, 64 * kb, 32 * nb, 32 * nb, nullptr, scr, lane); continue; } r -= I_SQ;
            if (r < I_SQ) { const int kb = r / 32, nb = r % 32; transpose_item<false>(w_br_mem, 1024, BRMEM, 1024, 64 * kb, 32 * nb, 32 * nb, nullptr, scr, lane); continue; } r -= I_SQ;
            if (r < I_SQ) { const int kb = r / 32, nb = r % 32; transpose_item<false>(w_out, 1024, WOUT, 1024, 64 * kb, 32 * nb, 32 * nb, nullptr, scr, lane); continue; } r -= I_SQ;
            { const int b = r / 128, q = r % 128, kb = q / 32, nb = q % 32;
              transpose_item<true>(cache_v + (size_t)b * 262144, 1024, MVT + (size_t)(2 + b) * 262144, 256, 64 * kb, 32 * nb, 32 * nb, nullptr, scr, lane); }
        }
        for (int m = gw; m < T; m += 2 * NGW) {
            const int m2 = m + NGW; const bool two = m2 < T;
            const float* xa = m < TP ? x_prompt + (size_t)m * 1024 : x_sample + (size_t)(m - TP) * 1024;
            const float* xb = !two ? xa : (m2 < TP ? x_prompt + (size_t)m2 * 1024 : x_sample + (size_t)(m2 - TP) * 1024);
            f32x4 va[4], vb[4]; float sa = 0.f, sb = 0.f;
#pragma unroll
            for (int j = 0; j < 4; ++j) { va[j] = ((const f32x4*)xa)[lane + 64 * j]; vb[j] = ((const f32x4*)xb)[lane + 64 * j]; }
#pragma unroll
            for (int j = 0; j < 4; ++j) { sa += (va[j][0] * va[j][0] + va[j][1] * va[j][1]) + (va[j][2] * va[j][2] + va[j][3] * va[j][3]); sb += (vb[j][0] * vb[j][0] + vb[j][1] * vb[j][1]) + (vb[j][2] * vb[j][2] + vb[j][3] * vb[j][3]); }
            const float ra = rsqrtf(wave_sum(sa) * (1.f / 1024.f) + EPS), rb = rsqrtf(wave_sum(sb) * (1.f / 1024.f) + EPS);
#pragma unroll
            for (int j = 0; j < 4; ++j) { const f32x4 gg = ((const f32x4*)g_mix)[lane + 64 * j];
                u32x2 w; w.x = pk2(va[j][0] * ra * gg[0], va[j][1] * ra * gg[1]); w.y = pk2(va[j][2] * ra * gg[2], va[j][3] * ra * gg[3]); ((u32x2*)(HN + (size_t)m * 1024))[lane + 64 * j] = w;
                if (two) { u32x2 w2; w2.x = pk2(vb[j][0] * rb * gg[0], vb[j][1] * rb * gg[1]); w2.y = pk2(vb[j][2] * rb * gg[2], vb[j][3] * rb * gg[3]); ((u32x2*)(HN + (size_t)m2 * 1024))[lane + 64 * j] = w2; } }
        }
        for (int m = gw; m < 512; m += NGW) row_norm_bf16(mem_prompt + (size_t)m * 1024, g_mem, MEMN + (size_t)m * 1024, lane, true);
        for (int m = gw; m < 2048; m += NGW) row_norm_bf16(cache_k + (size_t)m * 1024, nullptr, MKB + (size_t)(512 + m) * 1024, lane, false);
    }
    xcd_barrier(xbar);

#ifndef SCAN_PROBE_MODE
#define SCAN_PROBE_MODE 0
#endif
#ifndef REP_SK3
#define REP_SK3 1
#endif
#ifndef XBAR_TWICE
#define XBAR_TWICE 0
#endif
#ifndef REP_P12
#define REP_P12 0
#endif
#ifndef P2_MASK_FIRST
#define P2_MASK_FIRST 15
#endif
    for (int rep12_ = 0; rep12_ <= REP_P12; ++rep12_) {
    if (rep12_) { PHASE_IDS(); for (int i_ = blk * 512 + tid; i_ < T * 8; i_ += G * 512) STAT[i_] = 0.f; if (blk == 0 && tid < 3) queue[64 * tid] = 0u; xcd_barrier(xbar); }
#ifndef SKIP_P1
    for (int rep_ = 0; rep_ < REP_P1; ++rep_)
    {
        pg8::Gemm g{HN, WIN, T, 8192, 1024}; pg8::StaticOrder S; S.init(T, 8192, G, blk);
        EpiZ1a E{QK, Vb, CB, Pb, MQ};
        pg8::gemm_phase<EpiZ1a, pg8::StaticOrder, true, true>(lds, g, S, E);
        if (rep12_ == 0) {
        pg8::Gemm g2{MEMN, WMEMKV, 512, 2048, 1024}; pg8::StaticOrder S2; S2.init(512, 2048, G, (blk + G - 32) % G);
        EpiMemKV E2{out + O_MKP, out + O_MVP, MKB, MVT};
        pg8::gemm_phase<EpiMemKV, pg8::StaticOrder, true, true>(lds, g2, S2, E2);
        }
    }
#endif
    xcd_barrier(xbar); if (XBAR_TWICE) xcd_barrier(xbar);

#ifndef SKIP_P2
    {
        PHASE_IDS();
        LAS volatile int* qs = (LAS volatile int*)(lds + LDS_CTLOFF);
        constexpr int U_SCANP = 128, U_SCANS = 512, U_ATT = 520, U_CONV = 520;
#define QUEUE_NEXT(word, uu) do { if (tid == 0) *qs = (int)atomicAdd(queue + (word), 1u); __syncthreads(); uu = *qs; __syncthreads(); } while (0)
        for (;;) {
            int uu; QUEUE_NEXT(0, uu);
            if (uu >= U_SCANP + U_SCANS) break;
            if (REP_P12 && rep12_ == 0 && !((P2_MASK_FIRST >> (uu < U_SCANP ? 0 : 1)) & 1)) continue;
            int row0, nch, h, es; const float* S0; float* So;
            if (uu < U_SCANP) { const int bh = uu >> 4; es = uu & 15; h = bh & 3; row0 = (bh >> 2) * 8192; nch = 256; S0 = nullptr; So = out + O_RETP + (size_t)bh * 131072; }
            else { const int v = uu - U_SCANP, bh = v >> 4; es = v & 15; h = bh & 3; row0 = TP + (bh >> 2) * 32; nch = 1; S0 = state_ret + (size_t)bh * 131072; So = out + O_RETS + (size_t)bh * 131072; }
            const float log2g = log2f(1.f - exp2f(-5.f - (float)h));
            { int pm_ = 0; if (REP_P12 && rep12_ == 0) { pm_ = SCAN_PROBE_MODE & 7; if (SCAN_PROBE_MODE & 8) nch = nch > 1 ? nch / 2 : 1; }
              scan_unit(lds, QK, Vb, STAT, row0, nch, h, es, S0, So, log2g, pm_); }
        }
        for (;;) {
            int uu; QUEUE_NEXT(64, uu);
            if (uu >= U_ATT) break;
            if (REP_P12 && rep12_ == 0 && !((P2_MASK_FIRST >> 2) & 1)) continue;
            const int tile = uu >> 2, h = uu & 3, t0 = tile * 128 + wave * 16;
            const int bb = t0 < TP ? (t0 >> 13) : 2 + ((t0 - TP) >> 5);
            if (tile < 128) attn_unit_lds(lds, MQ, MKB + (size_t)bb * 262144, MVT + (size_t)bb * 262144, tile * 128, h);
            else attn_wave(MQ, MKB + (size_t)bb * 262144, MVT + (size_t)bb * 262144, t0, h, lane);
        }
        for (;;) {
            int uu; QUEUE_NEXT(128, uu);
            if (uu >= U_CONV) break;
            if (REP_P12 && rep12_ == 0 && !((P2_MASK_FIRST >> 3) & 1)) continue;
            { int t2 = tid; asm volatile("" : "+v"(t2)); conv_item(uu * 512 + t2, CB, Pb, w_conv, state_conv, out + O_CONVP, out + O_CONVS); }
        }
#undef QUEUE_NEXT
    }
#endif
    xcd_barrier(xbar); if (XBAR_TWICE) xcd_barrier(xbar);

    }
#ifdef PROBE_P2B
    { PHASE_IDS(); LAS float* scr = (LAS float*)(lds + wave * 16384);
      for (int it = gw; it < 16 * 176 + 44 * 32; it += NGW) {
            if (it < 16 * 176) { const int kb = it / 176, nb = it % 176; transpose_item<false>(w_ffn_in, 5632, FFNIN, 1024, 64 * kb, 32 * nb, map_ffn(32 * nb), g_ffn, scr, lane); }
            else { const int r = it - 16 * 176, kb = r / 32, nb = r % 32; transpose_item<false>(w_ffn_down, 1024, FFNDN, DFF, 64 * kb, 32 * nb, 32 * nb, nullptr, scr, lane); } }
      __syncthreads();
      pg8::Gemm g{HN, WIN + (size_t)8192 * 1024, T, 2048, 1024}; pg8::StaticOrder S; S.init(T, 2048, G, blk); EpiNull E{queue + 200, SS2};
      pg8::gemm_phase<EpiNull, pg8::StaticOrder, true, true>(lds, g, S, E); }
#endif
#ifndef SKIP_P2B
    {
        PHASE_IDS(); LAS float* scr = (LAS float*)(lds + wave * 16384);
        constexpr int I_FIN = 16 * 176, I_FDN = 44 * 32;
        for (int it = gw; it < I_FIN + I_FDN; it += NGW) {
            if (it < I_FIN) { const int kb = it / 176, nb = it % 176; transpose_item<false>(w_ffn_in, 5632, FFNIN, 1024, 64 * kb, 32 * nb, map_ffn(32 * nb), g_ffn, scr, lane); }
            else { const int r = it - I_FIN, kb = r / 32, nb = r % 32; transpose_item<false>(w_ffn_down, 1024, FFNDN, DFF, 64 * kb, 32 * nb, 32 * nb, nullptr, scr, lane); }
        }
        for (int pc_ = blk; pc_ < 512; pc_ += G) {
            const int strip = pc_ >> 2, n0 = 16 * strip, rq = pc_ & 3, h_ = strip >> 5, g4 = lane >> 4, li = lane & 15;
            LAS float* sst = (LAS float*)(lds + 32768);
            __syncthreads();
            {
                u32x4 w_[8];
#pragma unroll
                for (int k8 = 0; k8 < 8; ++k8) w_[k8] = *(const u32x4*)(Vb + (size_t)(TP + 64 * rq + wave + 8 * k8) * 2048 + h_ * 512 + lane * 8);
#pragma unroll
                for (int k8 = 0; k8 < 8; ++k8) {
                    const int rr_ = wave + 8 * k8;
                    const float a0_ = bflo(w_[k8].x), a1_ = bfhi(w_[k8].x), a2_ = bflo(w_[k8].y), a3_ = bfhi(w_[k8].y), a4_ = bflo(w_[k8].z), a5_ = bfhi(w_[k8].z), a6_ = bflo(w_[k8].w), a7_ = bfhi(w_[k8].w);
                    float s1_ = ((a0_ + a1_) + (a2_ + a3_)) + ((a4_ + a5_) + (a6_ + a7_)), s2_ = ((a0_ * a0_ + a1_ * a1_) + (a2_ * a2_ + a3_ * a3_)) + ((a4_ * a4_ + a5_ * a5_) + (a6_ * a6_ + a7_ * a7_));
                    s1_ = wave_sum(s1_); s2_ = wave_sum(s2_);
                    if (lane == 0) { sst[2 * rr_] = s1_; sst[2 * rr_ + 1] = s2_; }
                }
            }
            const f32x4 ac = skinny_gemm(lds, HN + (size_t)TP * 1024, 1024, WIN + (size_t)8192 * 1024, n0, rq, wave, lane);
            if (wave < 4) {
                const int rl = 16 * wave + li; const size_t po = (size_t)(TP + 64 * rq + rl) * 2048 + n0 + 4 * g4;
                const float mu = sst[2 * rl] * (1.f / 512.f), var = fmaxf(sst[2 * rl + 1] * (1.f / 512.f) - mu * mu, 0.f), rstd = rsqrtf(var + EPS);
                const u32x2 ov = *(const u32x2*)(Vb + po); const f32x4 gv = *(const f32x4*)(g_ret_gn + n0 + 4 * g4);
                const float o0 = bflo(ov.x), o1 = bfhi(ov.x), o2 = bflo(ov.y), o3 = bfhi(ov.y);
                u32x2 w; w.x = pk2((o0 - mu) * rstd * gv[0] * silu_f(ac[0]), (o1 - mu) * rstd * gv[1] * silu_f(ac[1])); w.y = pk2((o2 - mu) * rstd * gv[2] * silu_f(ac[2]), (o3 - mu) * rstd * gv[3] * silu_f(ac[3]));
                *(u32x2*)(ORNB + po) = w;
            }
        }
        __syncthreads();
        pg8::StaticOrder S; S.init(TP, 2048, G, blk);
        {
            Unit u_;
            for (int i_ = 0; S.next(i_, u_); ++i_) {
                const int h_ = u_.pn >> 1;
                for (int rb_ = 0; rb_ < 32; rb_ += 8) {
                    u32x4 w_[8];
#pragma unroll
                    for (int k8 = 0; k8 < 8; ++k8) w_[k8] = *(const u32x4*)(Vb + (size_t)(u_.pm * 256 + wave + 8 * (rb_ + k8)) * 2048 + h_ * 512 + lane * 8);
#pragma unroll
                    for (int k8 = 0; k8 < 8; ++k8) {
                        const int r_ = u_.pm * 256 + wave + 8 * (rb_ + k8);
                        const float a0_ = bflo(w_[k8].x), a1_ = bfhi(w_[k8].x), a2_ = bflo(w_[k8].y), a3_ = bfhi(w_[k8].y), a4_ = bflo(w_[k8].z), a5_ = bfhi(w_[k8].z), a6_ = bflo(w_[k8].w), a7_ = bfhi(w_[k8].w);
                        float s1_ = ((a0_ + a1_) + (a2_ + a3_)) + ((a4_ + a5_) + (a6_ + a7_)), s2_ = ((a0_ * a0_ + a1_ * a1_) + (a2_ * a2_ + a3_ * a3_)) + ((a4_ * a4_ + a5_ * a5_) + (a6_ * a6_ + a7_ * a7_));
                        s1_ = wave_sum(s1_); s2_ = wave_sum(s2_);
                        if (lane == 0) { STAT[(size_t)r_ * 8 + 2 * h_] = s1_; STAT[(size_t)r_ * 8 + 2 * h_ + 1] = s2_; }
                    }
                }
            }
            __threadfence_block();
        }
        __syncthreads();
        pg8::Gemm g{HN, WIN + (size_t)8192 * 1024, TP, 2048, 1024};
        EpiGR E{Vb, ORNB, STAT, g_ret_gn};
        pg8::gemm_phase<EpiGR, pg8::StaticOrder, true, true>(lds, g, S, E);
    }
#endif
    xcd_barrier(xbar); if (XBAR_TWICE) xcd_barrier(xbar);

#ifndef SKIP_P3
    for (int rep_ = 0; rep_ < REP_P3; ++rep_)
    {
        {
            PHASE_IDS(); for (int rsk_ = 0; rsk_ < REP_SK3; ++rsk_) for (int pc_ = blk; pc_ < 256; pc_ += G) { const int n0 = 16 * (pc_ >> 2), rq = pc_ & 3, g4 = lane >> 4, li = lane & 15;
            const bf16_t* HNs = HN + (size_t)TP * 1024;
            f32x4 gt = skinny_gemm(lds, HNs, 1024, WIN + (size_t)10240 * 1024, n0, rq, wave, lane), br = skinny_gemm(lds, ORNB + (size_t)TP * 2048, 2048, BRRET, n0, rq, wave, lane), mg;
#pragma unroll
            for (int i = 0; i < 4; ++i) mg[i] = sigm_f(gt[i]) * br[i];
            gt = skinny_gemm(lds, HNs, 1024, WIN + (size_t)11264 * 1024, n0, rq, wave, lane); br = skinny_gemm(lds, CB + (size_t)TP * 1024, 1024, BRCONV, n0, rq, wave, lane);
#pragma unroll
            for (int i = 0; i < 4; ++i) mg[i] += sigm_f(gt[i]) * br[i];
            gt = skinny_gemm(lds, HNs, 1024, WIN + (size_t)12288 * 1024, n0, rq, wave, lane); br = skinny_gemm(lds, MQ + (size_t)TP * 1024, 1024, BRMEM, n0, rq, wave, lane);
#pragma unroll
            for (int i = 0; i < 4; ++i) mg[i] += sigm_f(gt[i]) * br[i];
            if (wave < 4) { u32x2 w; w.x = pk2(mg[0], mg[1]); w.y = pk2(mg[2], mg[3]); *(u32x2*)(MERGED + (size_t)(TP + 64 * rq + 16 * wave + li) * 1024 + n0 + 4 * g4) = w; }
            __syncthreads(); }
        }
        pg8::StaticOrder S; S.init(TP, 1024, G, blk);
        EpiGate EG{STASH};
        { pg8::Gemm g{HN, WIN + (size_t)10240 * 1024, TP, 1024, 1024}; pg8::gemm_phase<EpiGate, pg8::StaticOrder, true, true>(lds, g, S, EG); }
        { pg8::Gemm g{ORNB, BRRET, TP, 1024, 2048}; EpiBranch<true> E{STASH, MERGED}; pg8::gemm_phase<EpiBranch<true>, pg8::StaticOrder, true, true>(lds, g, S, E); }
        { pg8::Gemm g{HN, WIN + (size_t)11264 * 1024, TP, 1024, 1024}; pg8::gemm_phase<EpiGate, pg8::StaticOrder, true, true>(lds, g, S, EG); }
        { pg8::Gemm g{CB, BRCONV, TP, 1024, 1024}; EpiBranch<false> E{STASH, MERGED}; pg8::gemm_phase<EpiBranch<false>, pg8::StaticOrder, true, true>(lds, g, S, E); }
        { pg8::Gemm g{HN, WIN + (size_t)12288 * 1024, TP, 1024, 1024}; pg8::gemm_phase<EpiGate, pg8::StaticOrder, true, true>(lds, g, S, EG); }
        { pg8::Gemm g{MQ, BRMEM, TP, 1024, 1024}; EpiBranch<false> E{STASH, MERGED}; pg8::gemm_phase<EpiBranch<false>, pg8::StaticOrder, true, true>(lds, g, S, E); }
    }
#endif
    xcd_barrier(xbar); if (XBAR_TWICE) xcd_barrier(xbar);

#ifdef PROBE_P4
    { pg8::Gemm g{MERGED, WOUT, TP, 1024, 1024}; pg8::StaticOrder S; S.init(TP, 1024, G, blk); EpiNull E{queue + 200, SS2};
      pg8::gemm_phase<EpiNull, pg8::StaticOrder, true, true>(lds, g, S, E); }
#endif
#ifndef SKIP_P4
    {
        {
            PHASE_IDS(); for (int pc_ = blk; pc_ < 256; pc_ += G) { const int n0 = 16 * (pc_ >> 2), rq = pc_ & 3, g4 = lane >> 4, li = lane & 15;
            const f32x4 ac = skinny_gemm(lds, MERGED + (size_t)TP * 1024, 1024, WOUT, n0, rq, wave, lane);
            if (wave < 4) {
                const int rs_ = 64 * rq + 16 * wave + li; const size_t off = (size_t)(TP + rs_) * 1024 + n0 + 4 * g4;
                const f32x4 v = *(const f32x4*)(x_sample + (size_t)rs_ * 1024 + n0 + 4 * g4) + ac;
                *(f32x4*)(X1 + off) = v; u32x2 w; w.x = pk2(v[0], v[1]); w.y = pk2(v[2], v[3]); *(u32x2*)(X1B + off) = w;
                float q = (v[0] * v[0] + v[1] * v[1]) + (v[2] * v[2] + v[3] * v[3]); q += __shfl_xor(q, 16); q += __shfl_xor(q, 32);
                if (g4 == 0) atomicAdd(SS1 + TP + rs_, q);
            }
            __syncthreads(); }
        }
        pg8::Gemm g{MERGED, WOUT, TP, 1024, 1024}; pg8::StaticOrder S; S.init(TP, 1024, G, blk);
        EpiRes<true> E{x_prompt, x_sample, X1, X1B, SS1};
        pg8::gemm_phase<EpiRes<true>, pg8::StaticOrder, true, true>(lds, g, S, E);
    }
#endif
    xcd_barrier(xbar); if (XBAR_TWICE) xcd_barrier(xbar);

#ifndef SKIP_P5
    for (int rep_ = 0; rep_ < REP_P5; ++rep_)
    {
        pg8::Gemm g{X1B, FFNIN, T, 5632, 1024}; pg8::StaticOrder S; S.init(T, 5632, G, blk);
        EpiUp E{ABUF, UBUF, SS1, out + O_FFNP, out + O_FFNS};
        pg8::gemm_phase<EpiUp, pg8::StaticOrder, true, true>(lds, g, S, E);
    }
#endif
    xcd_barrier(xbar); if (XBAR_TWICE) xcd_barrier(xbar);

#ifdef PROBE_P5B
    { PHASE_IDS(); const bool dz = queue[200] == 12345u;
      for (int it = blk * 512 + tid; it < 2080 * 352; it += G * 512) act_item(it, ABUF, UBUF, w_ffn_conv, state_ffn, dz); }
#endif
#ifndef SKIP_P5B
    { PHASE_IDS();
      for (int it = blk * 512 + tid; it < 2080 * 352; it += G * 512) act_item(it, ABUF, UBUF, w_ffn_conv, state_ffn); }
#endif
    xcd_barrier(xbar); if (XBAR_TWICE) xcd_barrier(xbar);

#ifdef PROBE_P6
    { pg8::Gemm g{UBUF, FFNDN, TP, 1024, DFF}; pg8::StaticOrder S; S.init(TP, 1024, G, blk); EpiNull E{queue + 200, SS1};
      pg8::gemm_phase<EpiNull, pg8::StaticOrder, true, true>(lds, g, S, E); }
#endif
#ifndef SKIP_P6
    {
        unsigned* fincnt = (unsigned*)(ws + WS_CTL + CTL_FIN);
        const bool fusedfin = (G == 256);
        {
            PHASE_IDS(); for (int pc_ = blk; pc_ < 256; pc_ += G) { const int n0 = 16 * (pc_ >> 2), rq = pc_ & 3, g4 = lane >> 4, li = lane & 15;
            const f32x4 ac = skinny_gemm(lds, UBUF + (size_t)TP * DFF, DFF, FFNDN, n0, rq, wave, lane);
            const int rs_ = 64 * rq + 16 * (wave & 3) + li; const size_t off = (size_t)(TP + rs_) * 1024 + n0 + 4 * g4;
            f32x4 v = {0.f, 0.f, 0.f, 0.f};
            if (wave < 4) {
                v = *(const f32x4*)(X1 + off) + ac;
                if (!fusedfin) *(f32x4*)(X1 + off) = v;
                float q = (v[0] * v[0] + v[1] * v[1]) + (v[2] * v[2] + v[3] * v[3]); q += __shfl_xor(q, 16); q += __shfl_xor(q, 32);
                if (g4 == 0) atomicAdd(SS2 + TP + rs_, q);
            }
            if (fusedfin) {
                panel_arrive_and_wait(fincnt + 16 * (64 + rq), 64u);
                if (wave < 4) { const float rs = rsqrtf(ld_agent_f(SS2 + TP + rs_) * (1.f / 1024.f) + EPS); *(f32x4*)(X1 + off) = v * rs * *(const f32x4*)(g_final + n0 + 4 * g4); }
            }
            __syncthreads(); }
        }
        pg8::Gemm g{UBUF, FFNDN, TP, 1024, DFF}; pg8::StaticOrder S; S.init(TP, 1024, G, blk);
        if (fusedfin) {
            EpiFinal E{X1, X1, SS2, fincnt, g_final};
            pg8::gemm_phase<EpiFinal, pg8::StaticOrder, false, true>(lds, g, S, E);
        } else {
            EpiRes<false> E{X1, X1 + (size_t)TP * 1024, X1, nullptr, SS2};
            pg8::gemm_phase<EpiRes<false>, pg8::StaticOrder, true, true>(lds, g, S, E);
        }
    }
#endif
    if (G != 256) { xcd_barrier(xbar); }

#ifdef PROBE_P7
    { PHASE_IDS(); const bool dz = queue[200] == 12345u;
    for (int m = gw; m < T; m += NGW) {
        float* row = X1 + (size_t)m * 1024; const float rs = rsqrtf(SS2[m] * (1.f / 1024.f) + EPS);
#pragma unroll
        for (int j = 0; j < 4; ++j) { f32x4 v = ((f32x4*)row)[lane + 64 * j]; const f32x4 gg = ((const f32x4*)g_final)[lane + 64 * j]; if (dz) ((f32x4*)row)[lane + 64 * j] = v * rs * gg; }
    } }
#endif
#ifndef SKIP_P7
    if (G != 256) { PHASE_IDS();
    for (int m = gw; m < T; m += NGW) {
        float* row = X1 + (size_t)m * 1024; const float rs = rsqrtf(SS2[m] * (1.f / 1024.f) + EPS);
#pragma unroll
        for (int j = 0; j < 4; ++j) { f32x4 v = ((f32x4*)row)[lane + 64 * j]; const f32x4 gg = ((const f32x4*)g_final)[lane + 64 * j]; ((f32x4*)row)[lane + 64 * j] = v * rs * gg; }
    }
    }
#endif
}

extern "C" void kernel_launch(void* const* d_in, const int* in_sizes, int n_in, void* d_out, int out_size, void* d_ws, size_t ws_size, hipStream_t stream) {
    static int grid = 0;
    if (grid == 0) {
        if (n_in != 23 || out_size != (int)O_TOTAL || ws_size < 512 * HMiB) { fprintf(stderr, "kernel_launch: unexpected shapes: n_in %d out %d ws %zu\n", n_in, out_size, ws_size); grid = -1; return; }
        int dev = 0, cus = 0, per_cu = 0;
        (void)hipGetDevice(&dev); (void)hipDeviceGetAttribute(&cus, hipDeviceAttributeMultiprocessorCount, dev);
        if (hipFuncSetAttribute((const void*)fwd_megakernel, hipFuncAttributeMaxDynamicSharedMemorySize, LDS_BYTES) != hipSuccess) { fprintf(stderr, "kernel_launch: hipFuncSetAttribute failed\n"); grid = -1; return; }
        if (hipOccupancyMaxActiveBlocksPerMultiprocessor(&per_cu, (const void*)fwd_megakernel, 512, LDS_BYTES) != hipSuccess || per_cu < 1) { fprintf(stderr, "kernel_launch: occupancy query says %d\n", per_cu); per_cu = 1; }
        (void)hipGetLastError();
        grid = cus > 0 ? cus : 256;
    }
    if (grid < 0) return;
    (void)hipMemsetAsync((char*)d_ws + WS_CTL, 0, CTL_BYTES, stream);
    Args a{};
    for (int i = 0; i < 23; ++i) a.in[i] = (const float*)d_in[i];
    a.out = (float*)d_out; a.ws = (unsigned char*)d_ws;
    void* kargs[] = {&a};
    hipError_t e = hipLaunchCooperativeKernel((const void*)fwd_megakernel, dim3(grid), dim3(512), kargs, LDS_BYTES, stream);
    if (e != hipSuccess) fprintf(stderr, "kernel_launch: cooperative launch failed: %s (grid %d)\n", hipGetErrorString(e), grid);
}
```

```cpp
#include <hip/hip_runtime.h>
#include <hip/hip_cooperative_groups.h>
#include <cstdio>
#include <cstdint>
namespace cg = cooperative_groups;
namespace pg8 {
#define PG8_LAS __attribute__((address_space(3)))
typedef unsigned short bf16_t;
typedef short bf16x8 __attribute__((ext_vector_type(8)));
typedef float f32x4 __attribute__((ext_vector_type(4)));
typedef unsigned u32x4 __attribute__((ext_vector_type(4)));
constexpr int BM = 256, BK = 64, HALF = 128, HTB = HALF * BK * 2  , STAGE_BYTES = 8 * HTB, NXCD = 8, WGM = 8;

__host__ __device__ __forceinline__ int lds_byte(int r, int c) { const int st = (r >> 4) * 2 + (c >> 5), rr = r & 15, cc = c & 31, ob = rr * 64 + cc * 2; return st * 1024 + (ob ^ (((ob >> 9) & 1) << 5)); }
__host__ __device__ __forceinline__ void stage_rc(int b, int& R, int& C) { const int st = b / 1024, sb = b % 1024, swz = sb ^ (((sb >> 9) & 1) << 5); R = (st >> 1) * 16 + swz / 64; C = (st & 1) * 32 + (swz % 64) / 2; }
__host__ __device__ __forceinline__ int perm32(int rho) { const int n = rho >> 4, i = rho & 15; return 8 * (i >> 2) + 4 * n + (i & 3); }

struct Unit { int pm, pn; };
struct Gemm { const bf16_t* A; const bf16_t* Bt; int M, N, K; };

struct StaticOrder {
    int nM, nN, nwg, G, c;
    __host__ __device__ __forceinline__ void init(int M, int N, int G_, int c_) { nM = M / BM; nN = N / BM; nwg = nM * nN; G = G_; c = c_; }
    __host__ __device__ __forceinline__ bool next(int i, Unit& u) const {
        const long L = (long)i * G + c; if (L >= nwg) return false;
        int wgid = (int)L; { const int q = nwg / NXCD, r = nwg % NXCD, xcd = wgid % NXCD, off = wgid / NXCD; wgid = (xcd < r ? xcd * (q + 1) : r * (q + 1) + (xcd - r) * q) + off; }
        const int nig = WGM * nN, gid = wgid / nig, fm = gid * WGM, gsz = (nM - fm) < WGM ? (nM - fm) : WGM;
        u.pm = fm + ((wgid % nig) % gsz); u.pn = (wgid % nig) / gsz; return true;
    }
    __device__ __forceinline__ void a_ready(const Unit&) const {}
    __device__ __forceinline__ void done(const Unit&) const {}
};
__device__ __forceinline__ unsigned cvt_pk_bf16(float lo, float hi) { unsigned r; asm volatile("v_cvt_pk_bf16_f32 %0, %1, %2" : "=v"(r) : "v"(lo), "v"(hi)); return r; }
template <class Epi, class Sched, bool ALIGN_EPI = false, bool SP2 = false>
__device__ __forceinline__ void gemm_phase(PG8_LAS unsigned char* lds, const Gemm g, const Sched& S, const Epi& E) {
    int tid_ = threadIdx.x; asm volatile("" : "+v"(tid_));
    const int tid = tid_, wid = __builtin_amdgcn_readfirstlane(tid >> 6), lane = tid & 63, wr = wid >> 2, wc = wid & 3, fr = lane & 15, fq = lane >> 4;
    const int K = g.K, nt = K / BK;
    unsigned voffA[2], voffB[2];
#pragma unroll
    for (int i = 0; i < 2; ++i) { int R, C; stage_rc(tid * 16 + i * 8192, R, C); const int Rb = Epi::PERM ? ((R & ~31) + perm32(R & 31)) : R;
        voffA[i] = (unsigned)(R * K + C) * 2u; voffB[i] = (unsigned)(Rb * K + C) * 2u; }
    const size_t kstep = (size_t)(BK * 2);
    const size_t hstep = (size_t)HALF * K * 2;
    const size_t tstep = 2 * hstep;
    const unsigned ldsw = (unsigned)wid * 1024u;
    const int aoff = lds_byte(wr * 64 + fr, fq * 8), boff = lds_byte(wc * 32 + fr, fq * 8);
#define PG8_SA(b, h) (((b) * 2 + (h)) * HTB)
#define PG8_SB(b, h) ((4 + (b) * 2 + (h)) * HTB)
#define PG8_STAGE(bufoff, gbase, voff) do { _Pragma("unroll") for (int _i = 0; _i < 2; ++_i) \
        __builtin_amdgcn_global_load_lds((const unsigned*)((const char*)(gbase) + (voff)[_i]), (PG8_LAS unsigned*)(lds + (bufoff) + ldsw + _i * 8192), 16, 0, 0); } while (0)
#define PG8_LDA(dst, b, h) do { _Pragma("unroll") for (int m = 0; m < 4; ++m) _Pragma("unroll") for (int k = 0; k < 2; ++k) dst[m][k] = *(const PG8_LAS bf16x8*)(lds + PG8_SA(b, h) + aoff + m * 2048 + k * 1024); } while (0)
#define PG8_LDB(dst, b, h) do { _Pragma("unroll") for (int n = 0; n < 2; ++n) _Pragma("unroll") for (int k = 0; k < 2; ++k) dst[n][k] = *(const PG8_LAS bf16x8*)(lds + PG8_SB(b, h) + boff + n * 2048 + k * 1024); } while (0)
#define PG8_MMA(ai, bj, At, Bt) do { __builtin_amdgcn_s_setprio(1); _Pragma("unroll") for (int m = 0; m < 4; ++m) _Pragma("unroll") for (int n = 0; n < 2; ++n) _Pragma("unroll") for (int k = 0; k < 2; ++k) \
        acc[ai][bj][m][n] = __builtin_amdgcn_mfma_f32_16x16x32_bf16(Bt[n][k], At[m][k], acc[ai][bj][m][n], 0, 0, 0); __builtin_amdgcn_s_setprio(0); } while (0)
#define PG8_WAIT_V(n) asm volatile("s_waitcnt vmcnt(" #n ")" ::: "memory")
#define PG8_WAIT_L(n) asm volatile("s_waitcnt lgkmcnt(" #n ")" ::: "memory")
#define PG8_BAR __builtin_amdgcn_s_barrier()
#define PG8_SCHED __builtin_amdgcn_sched_barrier(0)
    Unit cur, nxt; int ui = 0;
    if (!S.next(0, cur)) return;
    f32x4 acc[2][2][4][2];
#pragma unroll
    for (int a = 0; a < 2; ++a)
#pragma unroll
        for (int b = 0; b < 2; ++b)
#pragma unroll
            for (int m = 0; m < 4; ++m)
#pragma unroll
                for (int n = 0; n < 2; ++n) acc[a][b][m][n] = (f32x4){0.f, 0.f, 0.f, 0.f};
    bf16x8 At[4][2], B0[2][2], B1[2][2];
    const char* cA = (const char*)g.A + (size_t)cur.pm * tstep; const char* cB = (const char*)g.Bt + (size_t)cur.pn * tstep;
    S.a_ready(cur);
    if constexpr (SP2) {
        PG8_STAGE(PG8_SB(0, 0), cB, voffB); PG8_STAGE(PG8_SB(0, 1), cB + hstep, voffB); PG8_STAGE(PG8_SA(0, 0), cA, voffA); PG8_STAGE(PG8_SA(0, 1), cA + hstep, voffA);
        if (wr == 1) PG8_BAR;
        PG8_WAIT_V(2); PG8_BAR;
        PG8_STAGE(PG8_SB(1, 0), cB + kstep, voffB); PG8_STAGE(PG8_SA(1, 0), cA + kstep, voffA); PG8_STAGE(PG8_SB(1, 1), cB + hstep + kstep, voffB);
        PG8_WAIT_V(6); PG8_BAR;
    } else {
        PG8_STAGE(PG8_SB(0, 0), cB, voffB); PG8_STAGE(PG8_SA(0, 0), cA, voffA); PG8_STAGE(PG8_SB(0, 1), cB + hstep, voffB); PG8_STAGE(PG8_SA(0, 1), cA + hstep, voffA);
        if (wr == 1) PG8_BAR;
        PG8_WAIT_V(4); PG8_BAR;
        PG8_STAGE(PG8_SB(1, 0), cB + kstep, voffB); PG8_STAGE(PG8_SA(1, 0), cA + kstep, voffA); PG8_STAGE(PG8_SB(1, 1), cB + hstep + kstep, voffB);
        PG8_WAIT_V(6); PG8_BAR;
    }
    for (;;) {
        const bool has_next = S.next(ui + 1, nxt);
        const char* nA = has_next ? (const char*)g.A + (size_t)nxt.pm * tstep : cA; const char* nB = has_next ? (const char*)g.Bt + (size_t)nxt.pn * tstep : cB;
        for (int t = 0; t < nt; t += 2) {
            const bool last = (t == nt - 2);
            const char* a1 = cA + (size_t)(t + 1) * kstep;
            const char* a2 = last ? nA : cA + (size_t)(t + 2) * kstep; const char* b2 = last ? nB : cB + (size_t)(t + 2) * kstep;
            const char* a3 = a2 + kstep; const char* b3 = b2 + kstep;
            if (last && has_next) S.a_ready(nxt);
            if constexpr (SP2) {
            PG8_LDB(B0, 0, 0); PG8_LDB(B1, 0, 1); PG8_SCHED; PG8_LDA(At, 0, 0); PG8_STAGE(PG8_SA(1, 1), a1 + hstep, voffA);
            PG8_WAIT_V(8); PG8_WAIT_L(0); PG8_BAR; PG8_MMA(0, 0, At, B0); PG8_MMA(0, 1, At, B1); PG8_BAR; PG8_SCHED;
            PG8_LDA(At, 0, 1); PG8_STAGE(PG8_SB(0, 0), b2, voffB); PG8_STAGE(PG8_SB(0, 1), b2 + hstep, voffB); PG8_STAGE(PG8_SA(0, 0), a2, voffA);
            PG8_WAIT_V(8); PG8_WAIT_L(0); PG8_BAR; PG8_MMA(1, 0, At, B0); PG8_MMA(1, 1, At, B1); PG8_BAR; PG8_SCHED;
            PG8_LDB(B0, 1, 0); PG8_LDB(B1, 1, 1); PG8_SCHED; PG8_LDA(At, 1, 0); PG8_STAGE(PG8_SA(0, 1), a2 + hstep, voffA);
            PG8_WAIT_V(8); PG8_WAIT_L(0); PG8_BAR; PG8_MMA(0, 0, At, B0); PG8_MMA(0, 1, At, B1); PG8_BAR; PG8_SCHED;
            PG8_LDA(At, 1, 1); PG8_STAGE(PG8_SB(1, 0), b3, voffB); PG8_STAGE(PG8_SB(1, 1), b3 + hstep, voffB); PG8_STAGE(PG8_SA(1, 0), a3, voffA);
            PG8_WAIT_V(8); PG8_WAIT_L(0); PG8_BAR; PG8_MMA(1, 0, At, B0); PG8_MMA(1, 1, At, B1); PG8_BAR; PG8_SCHED;
            } else {
            PG8_LDB(B0, 0, 0); PG8_SCHED; PG8_LDA(At, 0, 0); PG8_STAGE(PG8_SA(1, 1), a1 + hstep, voffA);
            PG8_WAIT_L(8); PG8_BAR; PG8_WAIT_L(0); PG8_MMA(0, 0, At, B0); PG8_BAR; PG8_SCHED;
            PG8_LDB(B1, 0, 1); PG8_STAGE(PG8_SB(0, 0), b2, voffB);
            PG8_BAR; PG8_WAIT_L(0); PG8_MMA(0, 1, At, B1); PG8_BAR;
            PG8_LDA(At, 0, 1); PG8_STAGE(PG8_SA(0, 0), a2, voffA);
            PG8_BAR; PG8_WAIT_L(0); PG8_MMA(1, 0, At, B0); PG8_BAR; PG8_SCHED;
            PG8_STAGE(PG8_SB(0, 1), b2 + hstep, voffB);
            PG8_WAIT_V(6); PG8_BAR; PG8_MMA(1, 1, At, B1); PG8_BAR;
            PG8_LDB(B0, 1, 0); PG8_SCHED; PG8_LDA(At, 1, 0); PG8_STAGE(PG8_SA(0, 1), a2 + hstep, voffA);
            PG8_WAIT_L(8); PG8_BAR; PG8_WAIT_L(0); PG8_MMA(0, 0, At, B0); PG8_BAR; PG8_SCHED;
            PG8_LDB(B1, 1, 1); PG8_STAGE(PG8_SB(1, 0), b3, voffB);
            PG8_BAR; PG8_WAIT_L(0); PG8_MMA(0, 1, At, B1); PG8_BAR;
            PG8_LDA(At, 1, 1); PG8_STAGE(PG8_SA(1, 0), a3, voffA);
            PG8_BAR; PG8_WAIT_L(0); PG8_MMA(1, 0, At, B0); PG8_BAR; PG8_SCHED;
            PG8_STAGE(PG8_SB(1, 1), b3 + hstep, voffB);
            PG8_WAIT_V(6); PG8_BAR; PG8_MMA(1, 1, At, B1); PG8_BAR;
            }
        }
        if constexpr (ALIGN_EPI) { if (wr == 0) PG8_BAR; }
        if constexpr (!Epi::AFTER_DRAIN) { E(acc, cur, wr, wc, fr, fq); S.done(cur); }
        if (!has_next) break;
#pragma unroll
        for (int a = 0; a < 2; ++a)
#pragma unroll
            for (int b = 0; b < 2; ++b)
#pragma unroll
                for (int m = 0; m < 4; ++m)
#pragma unroll
                    for (int n = 0; n < 2; ++n) acc[a][b][m][n] = (f32x4){0.f, 0.f, 0.f, 0.f};
        cur = nxt; cA = nA; cB = nB; ++ui;
        if constexpr (ALIGN_EPI) { if (wr == 1) PG8_BAR; }
    }
    PG8_WAIT_V(0);
    if constexpr (!ALIGN_EPI) { if (wr == 0) PG8_BAR; }
    PG8_BAR;
    if constexpr (Epi::AFTER_DRAIN) { E.fused(acc, cur, wr, wc, fr, fq, lds, wid, lane); S.done(cur); }
#undef PG8_SA
#undef PG8_SB
#undef PG8_STAGE
#undef PG8_LDA
#undef PG8_LDB
#undef PG8_MMA
#undef PG8_WAIT_V
#undef PG8_WAIT_L
#undef PG8_BAR
#undef PG8_SCHED
}
}

using pg8::bf16_t; using pg8::f32x4; using pg8::bf16x8; using pg8::u32x4; using pg8::Unit;
#define LAS __attribute__((address_space(3)))
typedef unsigned u32x2 __attribute__((ext_vector_type(2)));
typedef short s16x4 __attribute__((ext_vector_type(4)));
typedef float f32x2_t __attribute__((ext_vector_type(2)));
typedef __bf16 bf16x2_t __attribute__((ext_vector_type(2)));

constexpr int TP = 16384, TSMP = 256, T = TP + TSMP, DM = 1024, DFF = 2816;
constexpr float EPS = 1e-6f;
constexpr size_t HMiB = 524288;
constexpr size_t WS_CTL = 0, CTL_BYTES = 2 * HMiB;
constexpr size_t WS_MKB = 2 * HMiB, WS_MVT = 12 * HMiB;
constexpr size_t WS_FFNIN = 2 * HMiB, WS_FFNDN = 24 * HMiB, WS_WOUT = 35 * HMiB, WS_BRRET = 39 * HMiB, WS_BRCONV = 47 * HMiB, WS_BRMEM = 51 * HMiB, WS_WIN = 55 * HMiB, WS_WMEMKV = 107 * HMiB;
constexpr size_t WS_HN = 115 * HMiB, WS_V = 180 * HMiB, WS_CB = 310 * HMiB, WS_P = 375 * HMiB, WS_MQ = 440 * HMiB, WS_END1 = 505 * HMiB;
constexpr size_t WS_MERGED = WS_P;
constexpr size_t WS_X1B = 39 * HMiB, WS_ABUF = 104 * HMiB, WS_UBUF = WS_ABUF + (size_t)T * DFF * 2, WS_END2 = WS_UBUF + (size_t)T * DFF * 2;
static_assert(WS_END2 <= 512 * HMiB && WS_END1 <= 512 * HMiB, "ws map");
constexpr size_t CTL_QUEUE = 0, CTL_SS1 = 4096, CTL_SS2 = 73728, CTL_STAT = 143360, CTL_FIN = 704512, CTL_XBAR = 720896;
static_assert(CTL_STAT + (size_t)T * 8 * 4 <= CTL_BYTES, "ctl");
constexpr size_t O_Y = 0, O_RETP = 17039360, O_CONVP = 18087936, O_FFNP = 18092032, O_MKP = 18103296, O_MVP = 18627584, O_RETS = 19151872, O_CONVS = 23346176, O_FFNS = 23362560, O_TOTAL = 23407616;
constexpr int LDS_BYTES = 147456, LDS_CTLOFF = LDS_BYTES - 128;

#ifndef REP_P0
#define REP_P0 1
#endif
#ifndef REP_P1
#define REP_P1 1
#endif
#ifndef REP_P3
#define REP_P3 1
#endif
#ifndef REP_P5
#define REP_P5 1
#endif
struct Args { const float* in[23]; float* out; unsigned char* ws; };

__device__ __forceinline__ unsigned pk2(float lo, float hi) { f32x2_t v = {lo, hi}; bf16x2_t b = __builtin_convertvector(v, bf16x2_t); return __builtin_bit_cast(unsigned, b); }
__device__ __forceinline__ float bflo(unsigned w) { return __builtin_bit_cast(float, w << 16); }
__device__ __forceinline__ float bfhi(unsigned w) { return __builtin_bit_cast(float, w & 0xffff0000u); }
__device__ __forceinline__ float sigm_f(float x) { return __builtin_amdgcn_rcpf(1.f + __expf(-x)); }
__device__ __forceinline__ float silu_f(float x) { return x * sigm_f(x); }
__device__ __forceinline__ f32x4 mfma16(bf16x8 a, bf16x8 b, f32x4 c) { return __builtin_amdgcn_mfma_f32_16x16x32_bf16(a, b, c, 0, 0, 0); }
__device__ __forceinline__ float wave_sum(float v) {
#pragma unroll
    for (int o = 1; o < 64; o <<= 1) v += __shfl_xor(v, o);
    return v;
}
__device__ __forceinline__ int tok_pos(int r) { return r < TP ? (r & 8191) : 1024 + ((r - TP) & 31); }
__device__ __forceinline__ bool tok_batch_start(int r) { return r < TP ? ((r & 8191) == 0) : (((r - TP) & 31) == 0); }

#define EPI_ARGS const f32x4 (&acc)[2][2][4][2], const Unit& u, int wr, int wc, int fr, int fq
__device__ __forceinline__ u32x4 pack8(const f32x4& a, const f32x4& b) { u32x4 w; w.x = pk2(a[0], a[1]); w.y = pk2(a[2], a[3]); w.z = pk2(b[0], b[1]); w.w = pk2(b[2], b[3]); return w; }

struct EpiZ1a {
    static constexpr bool PERM = true, AFTER_DRAIN = false;
    bf16_t *QK, *V, *CB, *P, *MQ;
    __device__ __forceinline__ void operator()(EPI_ARGS) const {
        const int row0 = u.pm * 256 + wr * 64 + fr, cl = wc * 32 + 8 * fq, pn = u.pn;
        if (pn < 8) {
            const float sc = pn >= 4 ? 0.0625f : 1.0f;
            float inv[8];
#pragma unroll
            for (int j = 0; j < 8; ++j) inv[j] = exp2f(-(float)(cl + j) * 0.10381025296523f) * 0.15915494309189535f;
#pragma unroll
            for (int ai = 0; ai < 2; ++ai)
#pragma unroll
                for (int m = 0; m < 4; ++m) {
                    const int r = row0 + ai * 128 + m * 16; const float pos = (float)tok_pos(r);
                    f32x4 o1[2], o2[2];
#pragma unroll
                    for (int n = 0; n < 2; ++n)
#pragma unroll
                        for (int i = 0; i < 4; ++i) {
                            float rev = pos * inv[4 * n + i]; rev -= floorf(rev);
                            const float s = __builtin_amdgcn_sinf(rev), c = __builtin_amdgcn_cosf(rev);
                            const float x1 = acc[ai][0][m][n][i], x2 = acc[ai][1][m][n][i];
                            o1[n][i] = (x1 * c - x2 * s) * sc; o2[n][i] = (x1 * s + x2 * c) * sc;
                        }
                    bf16_t* dst = QK + (size_t)pn * ((size_t)T * 256) + (size_t)r * 256 + cl;
                    *(u32x4*)dst = pack8(o1[0], o1[1]); *(u32x4*)(dst + 128) = pack8(o2[0], o2[1]);
                }
        } else if (pn < 20) {
            bf16_t* base; int ldc, c0;
            if (pn < 16) { base = V; ldc = 2048; c0 = (pn - 8) * 256; } else { base = CB; ldc = 1024; c0 = (pn - 16) * 256; }
#pragma unroll
            for (int ai = 0; ai < 2; ++ai)
#pragma unroll
                for (int m = 0; m < 4; ++m) {
                    bf16_t* dst = base + (size_t)(row0 + ai * 128 + m * 16) * ldc + c0 + cl;
#pragma unroll
                    for (int bj = 0; bj < 2; ++bj) *(u32x4*)(dst + bj * 128) = pack8(acc[ai][bj][m][0], acc[ai][bj][m][1]);
                }
        } else if (pn < 28) {
#pragma unroll
            for (int ai = 0; ai < 2; ++ai)
#pragma unroll
                for (int m = 0; m < 4; ++m) {
                    bf16_t* dst = P + (size_t)(row0 + ai * 128 + m * 16) * 1024 + (pn - 20) * 128 + cl;
                    *(u32x4*)dst = pack8(acc[ai][0][m][0] * acc[ai][1][m][0], acc[ai][0][m][1] * acc[ai][1][m][1]);
                }
        } else {
            const float sc = 0.0625f * 1.4426950408889634f;
#pragma unroll
            for (int ai = 0; ai < 2; ++ai)
#pragma unroll
                for (int m = 0; m < 4; ++m) {
                    bf16_t* dst = MQ + (size_t)(row0 + ai * 128 + m * 16) * 1024 + (pn - 28) * 256 + cl;
#pragma unroll
                    for (int bj = 0; bj < 2; ++bj) *(u32x4*)(dst + bj * 128) = pack8(acc[ai][bj][m][0] * sc, acc[ai][bj][m][1] * sc);
                }
        }
    }
};

struct EpiMemKV {
    static constexpr bool PERM = false, AFTER_DRAIN = false;
    float *outK, *outV; bf16_t *MKb, *MVt;
    __device__ __forceinline__ void operator()(EPI_ARGS) const {
        const int row0 = u.pm * 256 + wr * 64 + fr;
#pragma unroll
        for (int ai = 0; ai < 2; ++ai)
#pragma unroll
            for (int m = 0; m < 4; ++m) {
                const int r = row0 + ai * 128 + m * 16;
#pragma unroll
                for (int bj = 0; bj < 2; ++bj)
#pragma unroll
                    for (int n = 0; n < 2; ++n) {
                        const int c = u.pn * 256 + bj * 128 + wc * 32 + n * 16 + 4 * fq; const f32x4 v = acc[ai][bj][m][n];
                        if (u.pn < 4) { *(f32x4*)(outK + (size_t)r * 1024 + c) = v; u32x2 w; w.x = pk2(v[0], v[1]); w.y = pk2(v[2], v[3]); *(u32x2*)(MKb + (size_t)r * 1024 + c) = w; }
                        else {
                            const int cv = c - 1024; *(f32x4*)(outV + (size_t)r * 1024 + cv) = v;
                            const int b = r >> 8, mm = r & 255, pos = (mm & ~31) + 8 * ((mm >> 2) & 3) + 4 * ((mm >> 4) & 1) + (mm & 3);
#pragma unroll
                            for (int i = 0; i < 4; ++i) MVt[((size_t)b * 1024 + cv + i) * 256 + pos] = (bf16_t)(pk2(v[i], 0.f) & 0xffffu);
                        }
                    }
            }
    }
};

struct EpiGR {
    static constexpr bool PERM = true, AFTER_DRAIN = false;
    const bf16_t* O; bf16_t* ON; const float* stat; const float* ggn;
    __device__ __forceinline__ void operator()(EPI_ARGS) const {
        const int row0 = u.pm * 256 + wr * 64 + fr, cl = wc * 32 + 8 * fq, h = u.pn >> 1;
        f32x4 gv[2][2];
#pragma unroll
        for (int bj = 0; bj < 2; ++bj)
#pragma unroll
            for (int n = 0; n < 2; ++n) gv[bj][n] = *(const f32x4*)(ggn + u.pn * 256 + bj * 128 + cl + 4 * n);
#pragma unroll
        for (int ai = 0; ai < 2; ++ai) {
            u32x4 oq[4][2]; f32x2_t sq[4];
#pragma unroll
            for (int m = 0; m < 4; ++m) {
                const int r = row0 + ai * 128 + m * 16; sq[m] = *(const f32x2_t*)(stat + (size_t)r * 8 + 2 * h);
#pragma unroll
                for (int bj = 0; bj < 2; ++bj) oq[m][bj] = *(const u32x4*)(O + (size_t)r * 2048 + u.pn * 256 + bj * 128 + cl);
            }
            __builtin_amdgcn_sched_barrier(0);
#pragma unroll
            for (int m = 0; m < 4; ++m) {
                const int r = row0 + ai * 128 + m * 16;
                const float mu = sq[m].x * (1.f / 512.f), var = fmaxf(sq[m].y * (1.f / 512.f) - mu * mu, 0.f), rstd = rsqrtf(var + EPS);
#pragma unroll
                for (int bj = 0; bj < 2; ++bj) {
                    const size_t po = (size_t)r * 2048 + u.pn * 256 + bj * 128 + cl;
                    const u32x4 ov = oq[m][bj]; f32x4 o0, o1;
                    o0[0] = bflo(ov.x); o0[1] = bfhi(ov.x); o0[2] = bflo(ov.y); o0[3] = bfhi(ov.y); o1[0] = bflo(ov.z); o1[1] = bfhi(ov.z); o1[2] = bflo(ov.w); o1[3] = bfhi(ov.w);
                    f32x4 a0 = acc[ai][bj][m][0], a1 = acc[ai][bj][m][1];
#pragma unroll
                    for (int i = 0; i < 4; ++i) { a0[i] = (o0[i] - mu) * rstd * gv[bj][0][i] * silu_f(a0[i]); a1[i] = (o1[i] - mu) * rstd * gv[bj][1][i] * silu_f(a1[i]); }
                    *(u32x4*)(ON + po) = pack8(a0, a1);
                }
            }
        }
    }
};

struct EpiNull {
    static constexpr bool PERM = true, AFTER_DRAIN = false;
    const unsigned* flag; float* sink;
    __device__ __forceinline__ void operator()(EPI_ARGS) const {
        if (*flag == 12345u) {
#pragma unroll
            for (int ai = 0; ai < 2; ++ai)
#pragma unroll
                for (int m = 0; m < 4; ++m)
#pragma unroll
                    for (int bj = 0; bj < 2; ++bj) { sink[(u.pm * 256 + wr * 64 + fr + ai * 128 + m * 16) * 16 + wc + fq + bj] = acc[ai][bj][m][0][0] + acc[ai][bj][m][1][1]; }
        }
    }
};
struct EpiGate {
    static constexpr bool PERM = true, AFTER_DRAIN = false;
    bf16_t* S;
    __device__ __forceinline__ void operator()(EPI_ARGS) const {
        const int row0 = u.pm * 256 + wr * 64 + fr, cl = wc * 32 + 8 * fq;
#pragma unroll
        for (int ai = 0; ai < 2; ++ai)
#pragma unroll
            for (int m = 0; m < 4; ++m)
#pragma unroll
                for (int bj = 0; bj < 2; ++bj) {
                    f32x4 a0 = acc[ai][bj][m][0], a1 = acc[ai][bj][m][1];
#pragma unroll
                    for (int i = 0; i < 4; ++i) { a0[i] = sigm_f(a0[i]); a1[i] = sigm_f(a1[i]); }
                    *(u32x4*)(S + (size_t)(row0 + ai * 128 + m * 16) * 1024 + u.pn * 256 + bj * 128 + cl) = pack8(a0, a1);
                }
    }
};
template <bool FIRST> struct EpiBranch {
    static constexpr bool PERM = true, AFTER_DRAIN = false;
    const bf16_t* S; bf16_t* Mg;
    __device__ __forceinline__ void operator()(EPI_ARGS) const {
        const int row0 = u.pm * 256 + wr * 64 + fr, cl = wc * 32 + 8 * fq;
#pragma unroll
        for (int ai = 0; ai < 2; ++ai) {
            u32x4 gq[4][2], oq[4][2];
#pragma unroll
            for (int m = 0; m < 4; ++m)
#pragma unroll
                for (int bj = 0; bj < 2; ++bj) {
                    const size_t off = (size_t)(row0 + ai * 128 + m * 16) * 1024 + u.pn * 256 + bj * 128 + cl;
                    gq[m][bj] = *(const u32x4*)(S + off); if (!FIRST) oq[m][bj] = *(const u32x4*)(Mg + off);
                }
            __builtin_amdgcn_sched_barrier(0);
#pragma unroll
            for (int m = 0; m < 4; ++m)
#pragma unroll
                for (int bj = 0; bj < 2; ++bj) {
                    const size_t off = (size_t)(row0 + ai * 128 + m * 16) * 1024 + u.pn * 256 + bj * 128 + cl;
                    const u32x4 g = gq[m][bj];
                    f32x4 a0 = acc[ai][bj][m][0], a1 = acc[ai][bj][m][1];
                    a0[0] *= bflo(g.x); a0[1] *= bfhi(g.x); a0[2] *= bflo(g.y); a0[3] *= bfhi(g.y); a1[0] *= bflo(g.z); a1[1] *= bfhi(g.z); a1[2] *= bflo(g.w); a1[3] *= bfhi(g.w);
                    if (!FIRST) { const u32x4 o = oq[m][bj];
                        a0[0] += bflo(o.x); a0[1] += bfhi(o.x); a0[2] += bflo(o.y); a0[3] += bfhi(o.y); a1[0] += bflo(o.z); a1[1] += bfhi(o.z); a1[2] += bflo(o.w); a1[3] += bfhi(o.w); }
                    *(u32x4*)(Mg + off) = pack8(a0, a1);
                }
        }
    }
};

template <bool WITHB> struct EpiRes {
    static constexpr bool PERM = false, AFTER_DRAIN = false;
    const float* xp; const float* xs; float* xo; bf16_t* xb; float* ss;
    __device__ __forceinline__ void operator()(EPI_ARGS) const {
        const int row0 = u.pm * 256 + wr * 64 + fr;
#pragma unroll
        for (int ai = 0; ai < 2; ++ai) {
            f32x4 xv[4][2][2];
#pragma unroll
            for (int m = 0; m < 4; ++m) {
                const int r = row0 + ai * 128 + m * 16;
                const float* xin = r < TP ? xp + (size_t)r * 1024 : xs + (size_t)(r - TP) * 1024;
#pragma unroll
                for (int bj = 0; bj < 2; ++bj)
#pragma unroll
                    for (int n = 0; n < 2; ++n) xv[m][bj][n] = *(const f32x4*)(xin + u.pn * 256 + bj * 128 + wc * 32 + n * 16 + 4 * fq);
            }
            __builtin_amdgcn_sched_barrier(0);
#pragma unroll
            for (int m = 0; m < 4; ++m) {
                const int r = row0 + ai * 128 + m * 16;
                float q = 0.f;
#pragma unroll
                for (int bj = 0; bj < 2; ++bj)
#pragma unroll
                    for (int n = 0; n < 2; ++n) {
                        const int c = u.pn * 256 + bj * 128 + wc * 32 + n * 16 + 4 * fq;
                        const f32x4 v = xv[m][bj][n] + acc[ai][bj][m][n];
                        *(f32x4*)(xo + (size_t)r * 1024 + c) = v;
                        if (WITHB) { u32x2 w; w.x = pk2(v[0], v[1]); w.y = pk2(v[2], v[3]); *(u32x2*)(xb + (size_t)r * 1024 + c) = w; }
                        q += (v[0] * v[0] + v[1] * v[1]) + (v[2] * v[2] + v[3] * v[3]);
                    }
                q += __shfl_xor(q, 16); q += __shfl_xor(q, 32);
                if (fq == 0) atomicAdd(ss + r, q);
            }
        }
    }
};

__device__ __forceinline__ unsigned ld_agent(const unsigned* p) { return __hip_atomic_load(p, __ATOMIC_RELAXED, __HIP_MEMORY_SCOPE_AGENT); }
__device__ __forceinline__ float ld_agent_f(const float* p) { return __uint_as_float(__hip_atomic_load((const unsigned*)p, __ATOMIC_RELAXED, __HIP_MEMORY_SCOPE_AGENT)); }
__device__ __forceinline__ void panel_arrive_and_wait(unsigned* cnt, unsigned want) {
    asm volatile("s_waitcnt vmcnt(0)" ::: "memory");
    __syncthreads();
    if (threadIdx.x == 0) {
        __builtin_amdgcn_fence(__ATOMIC_RELEASE, "agent");
        asm volatile("s_waitcnt vmcnt(0)" ::: "memory");
        __hip_atomic_fetch_add(cnt, 1u, __ATOMIC_RELAXED, __HIP_MEMORY_SCOPE_AGENT);
        unsigned sp = 0;
        while (ld_agent(cnt) < want) { __builtin_amdgcn_s_sleep(2); if (++sp > (1u << 22)) break; }
        __builtin_amdgcn_fence(__ATOMIC_ACQUIRE, "agent");
    }
    __syncthreads();
}
struct EpiFinal {
    static constexpr bool PERM = false, AFTER_DRAIN = true;
    const float* x1; float* y; float* ss; unsigned* cnt; const float* gfin;
    __device__ __forceinline__ void operator()(EPI_ARGS) const {}
    __device__ __forceinline__ void fused(f32x4 (&acc)[2][2][4][2], const Unit& u, int wr, int wc, int fr, int fq, PG8_LAS unsigned char* lds, int wid, int lane) const {
        const int row0 = u.pm * 256 + wr * 64 + fr;
#pragma unroll
        for (int ai = 0; ai < 2; ++ai)
#pragma unroll
            for (int m = 0; m < 4; ++m) {
                const int r = row0 + ai * 128 + m * 16; float q = 0.f;
#pragma unroll
                for (int bj = 0; bj < 2; ++bj)
#pragma unroll
                    for (int n = 0; n < 2; ++n) {
                        const int c = u.pn * 256 + bj * 128 + wc * 32 + n * 16 + 4 * fq;
                        const f32x4 v = *(const f32x4*)(x1 + (size_t)r * 1024 + c) + acc[ai][bj][m][n];
                        acc[ai][bj][m][n] = v; q += (v[0] * v[0] + v[1] * v[1]) + (v[2] * v[2] + v[3] * v[3]);
                    }
                q += __shfl_xor(q, 16); q += __shfl_xor(q, 32);
                if (fq == 0) atomicAdd(ss + r, q);
            }
        panel_arrive_and_wait(cnt + 16 * u.pm, 4u);
#pragma unroll
        for (int ai = 0; ai < 2; ++ai)
#pragma unroll
            for (int m = 0; m < 4; ++m) {
                const int r = row0 + ai * 128 + m * 16; const float rs = rsqrtf(ld_agent_f(ss + r) * (1.f / 1024.f) + EPS);
#pragma unroll
                for (int bj = 0; bj < 2; ++bj)
#pragma unroll
                    for (int n = 0; n < 2; ++n) {
                        const int c = u.pn * 256 + bj * 128 + wc * 32 + n * 16 + 4 * fq;
                        *(f32x4*)(y + (size_t)r * 1024 + c) = acc[ai][bj][m][n] * rs * *(const f32x4*)(gfin + c);
                    }
            }
    }
};

struct EpiUp {
    static constexpr bool PERM = true, AFTER_DRAIN = false;
    bf16_t *A, *U; const float* ss; float *outP, *outS;
    __device__ __forceinline__ void operator()(EPI_ARGS) const {
        const int row0 = u.pm * 256 + wr * 64 + fr, ch = u.pn * 128 + wc * 32 + 8 * fq;
        float ssv[2][4];
#pragma unroll
        for (int ai = 0; ai < 2; ++ai)
#pragma unroll
            for (int m = 0; m < 4; ++m) ssv[ai][m] = ss[row0 + ai * 128 + m * 16];
        __builtin_amdgcn_sched_barrier(0);
#pragma unroll
        for (int ai = 0; ai < 2; ++ai)
#pragma unroll
            for (int m = 0; m < 4; ++m) {
                const int r = row0 + ai * 128 + m * 16; const float rs = rsqrtf(ssv[ai][m] * (1.f / 1024.f) + EPS);
                const f32x4 a0 = acc[ai][0][m][0] * rs, a1 = acc[ai][0][m][1] * rs;
                *(u32x4*)(A + (size_t)r * DFF + ch) = pack8(a0, a1);
                *(u32x4*)(U + (size_t)r * DFF + ch) = pack8(acc[ai][1][m][0] * rs, acc[ai][1][m][1] * rs);
                float* so = nullptr;
                if (r < TP) { const int t = r & 8191; if (t >= 8190) so = outP + ((size_t)(r >> 13) * 2 + (t - 8190)) * DFF; }
                else { const int t = (r - TP) & 31; if (t >= 30) so = outS + ((size_t)((r - TP) >> 5) * 2 + (t - 30)) * DFF; }
                if (so) { *(f32x4*)(so + ch) = a0; *(f32x4*)(so + ch + 4) = a1; }
            }
    }
};

template <bool PERMK>
__device__ __forceinline__ void transpose_item(const float* W, int N, bf16_t* WT, int ldt, int k0, int n0, int drow0, const float* kscale, LAS float* scr, int lane) {
    float tv[32];
#pragma unroll
    for (int i = 0; i < 32; ++i) tv[i] = W[(size_t)(k0 + 2 * i + (lane >> 5)) * N + n0 + (lane & 31)];
#pragma unroll
    for (int i = 0; i < 32; ++i) { const int kk = 2 * i + (lane >> 5); float v = tv[i]; if (kscale) v *= kscale[k0 + kk]; scr[kk * 33 + (lane & 31)] = v; }
    asm volatile("s_waitcnt lgkmcnt(0)" ::: "memory");
    const int c = lane & 7;
#pragma unroll
    for (int j = 0; j < 4; ++j) {
        const int n = (lane >> 3) + 8 * j; float e[8];
#pragma unroll
        for (int q = 0; q < 8; ++q) { const int kk = PERMK ? ((c >> 2) * 32 + 16 * (q >> 2) + 4 * (c & 3) + (q & 3)) : (8 * c + q); e[q] = scr[kk * 33 + n]; }
        u32x4 o; o.x = pk2(e[0], e[1]); o.y = pk2(e[2], e[3]); o.z = pk2(e[4], e[5]); o.w = pk2(e[6], e[7]);
        *(u32x4*)(WT + (size_t)(drow0 + n) * ldt + k0 + 8 * c) = o;
    }
    asm volatile("s_waitcnt lgkmcnt(0)" ::: "memory");
}
__device__ __forceinline__ int map_win(int n) {
    if (n < 4096) return n;
    if (n < 6144) return 8192 + (n - 4096);
    if (n < 7168) return 4096 + (n - 6144);
    if (n < 8192) { const int ch = n - 7168; return 5120 + (ch >> 7) * 256 + (ch & 127); }
    if (n < 9216) { const int ch = n - 8192; return 5120 + (ch >> 7) * 256 + 128 + (ch & 127); }
    if (n < 10240) return 7168 + (n - 9216);
    return n;
}
__device__ __forceinline__ int map_ffn(int c) { if (c < DFF) return (c >> 7) * 256 + (c & 127); c -= DFF; return (c >> 7) * 256 + 128 + (c & 127); }
__device__ __forceinline__ void row_norm_bf16(const float* xrow, const float* g, bf16_t* orow, int lane, bool norm) {
    f32x4 v[4]; float s = 0.f;
#pragma unroll
    for (int j = 0; j < 4; ++j) { v[j] = ((const f32x4*)xrow)[lane + 64 * j]; s += (v[j][0] * v[j][0] + v[j][1] * v[j][1]) + (v[j][2] * v[j][2] + v[j][3] * v[j][3]); }
    float rs = 1.f;
    if (norm) rs = rsqrtf(wave_sum(s) * (1.f / 1024.f) + EPS);
#pragma unroll
    for (int j = 0; j < 4; ++j) { f32x4 gg = norm ? ((const f32x4*)g)[lane + 64 * j] : (f32x4){1.f, 1.f, 1.f, 1.f}; u32x2 w; w.x = pk2(v[j][0] * rs * gg[0], v[j][1] * rs * gg[1]); w.y = pk2(v[j][2] * rs * gg[2], v[j][3] * rs * gg[3]); ((u32x2*)orow)[lane + 64 * j] = w; }
}

constexpr int SC_QS = 264, SC_KS = 272, SC_VS = 40, SC_SS = 40, SC_NCW = 2;
constexpr int SC_Q = 0, SC_K = 32 * SC_QS * 2, SC_V = SC_K + 32 * SC_KS * 2, SC_BUF = SC_V + 32 * SC_VS * 2, SC_S = 2 * SC_BUF, SC_SSZ = 32 * SC_SS * 2, SC_TOTAL = SC_S + 2 * SC_SSZ;
static_assert(SC_TOTAL <= 131072, "scan lds");
__device__ __forceinline__ s16x4 tr16(const LAS bf16_t* p) { typedef short v4i16 __attribute__((ext_vector_type(4))); return __builtin_bit_cast(s16x4, __builtin_amdgcn_ds_read_tr16_b64_v4i16((LAS v4i16*)p)); }
__device__ __forceinline__ bf16x8 cat8(s16x4 a, s16x4 b) { return (bf16x8){a[0], a[1], a[2], a[3], b[0], b[1], b[2], b[3]}; }

__device__ __forceinline__ void scan_scores(const LAS bf16_t* Qs, const LAS bf16_t* Ks, LAS bf16_t* Ss, int lane) {
    typedef float f32x16 __attribute__((ext_vector_type(16)));
    const int r32 = lane & 31, hh = lane >> 5;
    const LAS bf16_t* kp = Ks + r32 * SC_KS + 8 * hh; const LAS bf16_t* qp = Qs + r32 * SC_QS + 8 * hh;
    f32x16 sc = {0.f, 0.f, 0.f, 0.f, 0.f, 0.f, 0.f, 0.f, 0.f, 0.f, 0.f, 0.f, 0.f, 0.f, 0.f, 0.f};
#pragma unroll
    for (int half = 0; half < 2; ++half) {
        bf16x8 a[8], b[8];
#pragma unroll
        for (int s8 = 0; s8 < 8; ++s8) { a[s8] = *(const LAS bf16x8*)(kp + 16 * (8 * half + s8)); b[s8] = *(const LAS bf16x8*)(qp + 16 * (8 * half + s8)); }
#pragma unroll
        for (int s8 = 0; s8 < 8; ++s8) sc = __builtin_amdgcn_mfma_f32_32x32x16_bf16(a[s8], b[s8], sc, 0, 0, 0);
        __builtin_amdgcn_sched_barrier(0);
    }
#pragma unroll
    for (int q = 0; q < 4; ++q) {
        const int m0 = 8 * q + 4 * hh; float v[4];
#pragma unroll
        for (int i = 0; i < 4; ++i) v[i] = (m0 + i > r32) ? 0.f : sc[4 * q + i];
        u32x2 w; w.x = pk2(v[0], v[1]); w.y = pk2(v[2], v[3]);
        *(LAS u32x2*)(Ss + r32 * SC_SS + m0) = w;
    }
}
__device__ __forceinline__ void scan_scores16(const LAS bf16_t* Qs, const LAS bf16_t* Ks, LAS bf16_t* Ss, int lts, int mts, int g, int li) {
    f32x4 sc = {0.f, 0.f, 0.f, 0.f};
    const LAS bf16_t* kp = Ks + (16 * mts + li) * SC_KS + 8 * g; const LAS bf16_t* qp = Qs + (16 * lts + li) * SC_QS + 8 * g;
    bf16x8 a[8], b[8];
#pragma unroll
    for (int ks = 0; ks < 8; ++ks) { a[ks] = *(const LAS bf16x8*)(kp + 32 * ks); b[ks] = *(const LAS bf16x8*)(qp + 32 * ks); }
    f32x4 sc2 = {0.f, 0.f, 0.f, 0.f};
#pragma unroll
    for (int ks = 0; ks < 8; ks += 2) { sc = mfma16(a[ks], b[ks], sc); sc2 = mfma16(a[ks + 1], b[ks + 1], sc2); }
    sc = sc + sc2;
    const int l = 16 * lts + li;
#pragma unroll
    for (int i = 0; i < 4; ++i) if (16 * mts + 4 * g + i > l) sc[i] = 0.f;
    u32x2 w; w.x = pk2(sc[0], sc[1]); w.y = pk2(sc[2], sc[3]);
    *(LAS u32x2*)(Ss + l * SC_SS + 16 * mts + 4 * g) = w;
}
#define SCA_LDQ(F, kh) _Pragma("unroll") for (int k4 = 0; k4 < 4; ++k4) _Pragma("unroll") for (int l2 = 0; l2 < 2; ++l2) { \
        const LAS bf16_t* qp = Qs + (16 * l2 + li) * SC_QS + 32 * (4 * (kh) + k4) + 4 * g; F[2 * k4 + l2] = cat8(*(const LAS s16x4*)qp, *(const LAS s16x4*)(qp + 16)); }
__device__ __forceinline__ void scan_issue(bf16x8 (&F0)[8], bf16x8 (&F1)[8], bf16x8& vf, const LAS bf16_t* Qs, const LAS bf16_t* Vs, int wid, int g, int li) {
    const int q4 = li >> 2, p4 = li & 3;
    SCA_LDQ(F0, 0);
    vf = cat8(tr16(Vs + (4 * g + q4) * SC_VS + 16 * wid + 4 * p4), tr16(Vs + (16 + 4 * g + q4) * SC_VS + 16 * wid + 4 * p4));
    SCA_LDQ(F1, 1);
}
__device__ __forceinline__ void scan_main_a(f32x4 (&S)[16], f32x4 (&o)[2], bf16x8 (&F0)[8], bf16x8 (&F1)[8], const bf16x8 vf, const LAS bf16_t* Ks, int g, int li, float g32) {
    const int q4 = li >> 2, p4 = li & 3;
#define SCA_LDK(F, dh) _Pragma("unroll") for (int d8 = 0; d8 < 8; ++d8) { const int dt = 8 * (dh) + d8; \
        F[d8] = cat8(tr16(Ks + (4 * g + q4) * SC_KS + 16 * dt + 4 * p4), tr16(Ks + (16 + 4 * g + q4) * SC_KS + 16 * dt + 4 * p4)); }
#define SCA_CROSS(F, kh) _Pragma("unroll") for (int k4 = 0; k4 < 4; ++k4) { const int ks = 4 * (kh) + k4; \
        u32x4 aw; aw.x = pk2(S[2 * ks][0], S[2 * ks][1]); aw.y = pk2(S[2 * ks][2], S[2 * ks][3]); aw.z = pk2(S[2 * ks + 1][0], S[2 * ks + 1][1]); aw.w = pk2(S[2 * ks + 1][2], S[2 * ks + 1][3]); \
        const bf16x8 af = __builtin_bit_cast(bf16x8, aw); o[0] = mfma16(af, F[2 * k4], o[0]); o[1] = mfma16(af, F[2 * k4 + 1], o[1]); }
#define SCA_SUPD(F, dh) _Pragma("unroll") for (int d8 = 0; d8 < 8; ++d8) S[8 * (dh) + d8] = mfma16(F[d8], vf, S[8 * (dh) + d8]);
#pragma unroll
    for (int dt = 0; dt < 16; ++dt) S[dt] = S[dt] * g32;
    o[0] = (f32x4){0.f, 0.f, 0.f, 0.f}; o[1] = (f32x4){0.f, 0.f, 0.f, 0.f};
    __builtin_amdgcn_sched_barrier(0);
    SCA_CROSS(F0, 0);
    SCA_LDK(F0, 0);
    __builtin_amdgcn_sched_barrier(0);
    SCA_CROSS(F1, 1);
    SCA_LDK(F1, 1);
    __builtin_amdgcn_sched_barrier(0);
    SCA_SUPD(F0, 0);
    __builtin_amdgcn_sched_barrier(0);
    SCA_SUPD(F1, 1);
#undef SCA_LDK
#undef SCA_CROSS
#undef SCA_SUPD
}
#undef SCA_LDQ
__device__ __forceinline__ void scan_main_b(f32x4 (&o)[2], const bf16x8 vf, const LAS bf16_t* Ss, bf16_t* Vb, float* stat, size_t trow0, int ecol, int h, int wid, int g, int li, float log2g) {
#pragma unroll
    for (int l2 = 0; l2 < 2; ++l2) { const LAS bf16_t* sp_ = Ss + (16 * l2 + li) * SC_SS + 4 * g; const bf16x8 sb = cat8(*(const LAS s16x4*)sp_, *(const LAS s16x4*)(sp_ + 16)); o[l2] = mfma16(vf, sb, o[l2]); }
#pragma unroll
    for (int l2 = 0; l2 < 2; ++l2) {
        const int l = 16 * l2 + li; const float f = __builtin_amdgcn_exp2f((float)(l - 31) * log2g); const f32x4 v = o[l2] * f;
        const size_t trow = trow0 + l;
        u32x2 w; w.x = pk2(v[0], v[1]); w.y = pk2(v[2], v[3]);
        *(u32x2*)(Vb + trow * 2048 + ecol + 16 * wid + 4 * g) = w;
    }
}
struct ScanRegs { u32x4 q[4], k[4], v; };
__device__ __forceinline__ void scan_unit(LAS unsigned char* lds, const bf16_t* QK, bf16_t* Vb, float* stat, int row0, int nch, int h, int es, const float* S0, float* Sout, float log2g, int pmode = 0) {
    int tid_ = threadIdx.x; asm volatile("" : "+v"(tid_));
    const int tid = tid_, lane = tid & 63, wid = __builtin_amdgcn_readfirstlane(tid >> 6), g = lane >> 4, li = lane & 15;
    const bool loader = wid >= 4;
    const int lt = tid - 256;
    const int ecol = h * 512 + es * 32;
    const float g32 = exp2f(32.f * log2g);
#define SC_GLD(dst, ptr) asm volatile("global_load_dwordx4 %0, %1, off" : "=v"(dst) : "v"(ptr) : "memory")
#define SC_LOAD(c, R) do { const size_t rb = (size_t)(row0 + 32 * (c)); \
        _Pragma("unroll") for (int i = 0; i < 4; ++i) { const int id = lt + 256 * i, rr = id >> 5, cc = id & 31; const bf16_t* src = QK + (size_t)h * ((size_t)T * 256) + (rb + rr) * 256 + cc * 8; SC_GLD(R.q[i], src); SC_GLD(R.k[i], src + (size_t)4 * T * 256); } \
        { const int l2_ = lt & 127, rr = l2_ >> 2, cc = l2_ & 3; SC_GLD(R.v, Vb + (rb + rr) * 2048 + ecol + cc * 8); } } while (0)
#define SC_WAITV(n) asm volatile("s_waitcnt vmcnt(" #n ")" ::: "memory")
#define SC_SCALE(w, f) pk2(bflo(w) * (f), bfhi(w) * (f))
#define SC_WRITE(buf, R) do { LAS unsigned char* bb = lds + (buf) * SC_BUF; \
        _Pragma("unroll") for (int i = 0; i < 4; ++i) { const int id = lt + 256 * i, rr = id >> 5, cc = id & 31; \
            *(LAS u32x4*)(bb + SC_Q + (rr * SC_QS + cc * 8) * 2) = R.q[i]; *(LAS u32x4*)(bb + SC_K + (rr * SC_KS + cc * 8) * 2) = R.k[i]; } \
        if (lt < 128) { const int rr = lt >> 2, cc = lt & 3; const float vd = __builtin_amdgcn_exp2f((float)(31 - rr) * log2g); u32x4 vv; vv.x = SC_SCALE(R.v.x, vd); vv.y = SC_SCALE(R.v.y, vd); vv.z = SC_SCALE(R.v.z, vd); vv.w = SC_SCALE(R.v.w, vd); \
          *(LAS u32x4*)(bb + SC_V + (rr * SC_VS + cc * 8) * 2) = vv; } } while (0)
    LAS bf16_t* Ss = (LAS bf16_t*)(lds + SC_S);
    if (loader) {
        ScanRegs R0, R1, R2, R3;
        SC_LOAD(0, R0); SC_WAITV(0); __builtin_amdgcn_sched_barrier(0); SC_WRITE(0, R0);
        if (nch > 1) SC_LOAD(1, R1);
        if (nch > 2) SC_LOAD(2, R2);
        if (nch > 3) SC_LOAD(3, R3);
        __syncthreads();
#define SC_LSTEP(c, RFREE, RNEXT) do { if ((c) < nch) { if ((c) + 4 < nch && !(pmode & 2)) SC_LOAD((c) + 4, RFREE); \
            if (false) scan_scores((const LAS bf16_t*)(lds + ((c) & 1) * SC_BUF + SC_Q), (const LAS bf16_t*)(lds + ((c) & 1) * SC_BUF + SC_K), Ss, lane); \
            if ((c) + 4 < nch && !(pmode & 2)) SC_WAITV(27); else SC_WAITV(0); __builtin_amdgcn_sched_barrier(0); \
            if ((c) + 1 < nch && !(pmode & 2)) SC_WRITE(((c) + 1) & 1, RNEXT); __builtin_amdgcn_sched_barrier(0); __syncthreads(); } } while (0)
        for (int c = 0; c < nch; c += 4) { SC_LSTEP(c, R0, R1); SC_LSTEP(c + 1, R1, R2); SC_LSTEP(c + 2, R2, R3); SC_LSTEP(c + 3, R3, R0); }
#undef SC_LSTEP
    } else if (wid >= SC_NCW) {
        __syncthreads();
        for (int c = 0; c < nch; ++c) {
            const LAS bf16_t* Qs = (const LAS bf16_t*)(lds + (c & 1) * SC_BUF + SC_Q); const LAS bf16_t* Ks = (const LAS bf16_t*)(lds + (c & 1) * SC_BUF + SC_K);
            LAS bf16_t* Sc = (LAS bf16_t*)(lds + SC_S + (c & 1) * SC_SSZ);
            if (!(pmode & 4)) {
                if (wid == 2) { scan_scores16(Qs, Ks, Sc, 0, 0, g, li); scan_scores16(Qs, Ks, Sc, 1, 1, g, li); }
                else { scan_scores16(Qs, Ks, Sc, 1, 0, g, li); *(LAS u32x2*)(Sc + li * SC_SS + 16 + 4 * g) = (u32x2){0u, 0u}; }
            }
            __syncthreads();
        }
    } else {
        f32x4 S[16];
#pragma unroll
        for (int dt = 0; dt < 16; ++dt) S[dt] = (f32x4){0.f, 0.f, 0.f, 0.f};
        if (S0) {
            const float* sp = S0 + (size_t)(4 * g) * 512 + es * 32 + 16 * wid + li;
#pragma unroll
            for (int dt = 0; dt < 16; ++dt) {
#pragma unroll
                for (int i = 0; i < 4; ++i) S[dt][i] = sp[i * 512];
                sp += 16 * 512;
                if ((dt & 3) == 3) __builtin_amdgcn_sched_barrier(0);
            }
        }
        __syncthreads();
        bf16x8 F0[8], F1[8], vfn;
        scan_issue(F0, F1, vfn, (const LAS bf16_t*)(lds + SC_Q), (const LAS bf16_t*)(lds + SC_V), wid, g, li);
        for (int c = 0; c < nch; ++c) {
            const int cur = c & 1;
            const LAS bf16_t* Ks = (const LAS bf16_t*)(lds + cur * SC_BUF + SC_K);
            f32x4 o[2]; const bf16x8 vf = vfn;
            if (!(pmode & 1)) scan_main_a(S, o, F0, F1, vf, Ks, g, li, g32);
            __syncthreads();
            __builtin_amdgcn_sched_barrier(0);
            if (c + 1 < nch) scan_issue(F0, F1, vfn, (const LAS bf16_t*)(lds + (cur ^ 1) * SC_BUF + SC_Q), (const LAS bf16_t*)(lds + (cur ^ 1) * SC_BUF + SC_V), wid, g, li);
            __builtin_amdgcn_sched_barrier(0);
            if (!(pmode & 1)) scan_main_b(o, vf, (const LAS bf16_t*)(lds + SC_S + (c & 1) * SC_SSZ), Vb, stat, (size_t)(row0 + 32 * c), ecol, h, wid, g, li, log2g);
        }
        float* sp = Sout + (size_t)(4 * g) * 512 + es * 32 + 16 * wid + li;
#pragma unroll
        for (int dt = 0; dt < 16; ++dt) {
#pragma unroll
            for (int i = 0; i < 4; ++i) sp[i * 512] = S[dt][i];
            sp += 16 * 512;
            if ((dt & 3) == 3) __builtin_amdgcn_sched_barrier(0);
        }
    }
#undef SC_LOAD
#undef SC_GLD
#undef SC_WAITV
#undef SC_WRITE
#undef SC_SCALE
}

__device__ __forceinline__ void attn_wave(bf16_t* MQ, const bf16_t* Kb, const bf16_t* Vt, int t0, int h, int lane_) {
    int lane = lane_; asm volatile("" : "+v"(lane));
    const int g = lane >> 4, li = lane & 15;
    bf16x8 qf[8];
    bf16_t* qrow = MQ + (size_t)(t0 + li) * 1024 + h * 256;
#pragma unroll
    for (int ks = 0; ks < 8; ++ks) qf[ks] = *(const bf16x8*)(qrow + 32 * ks + 8 * g);
    f32x4 s[16];
#pragma unroll
    for (int mt = 0; mt < 16; ++mt) {
        s[mt] = (f32x4){0.f, 0.f, 0.f, 0.f};
        const bf16_t* kr = Kb + (size_t)(16 * mt + li) * 1024 + h * 256 + 8 * g;
#pragma unroll
        for (int ks = 0; ks < 8; ++ks) s[mt] = mfma16(*(const bf16x8*)(kr + 32 * ks), qf[ks], s[mt]);
    }
    float mx = -3.0e38f;
#pragma unroll
    for (int mt = 0; mt < 16; ++mt) mx = fmaxf(fmaxf(fmaxf(s[mt][0], s[mt][1]), fmaxf(s[mt][2], s[mt][3])), mx);
    mx = fmaxf(mx, __shfl_xor(mx, 16)); mx = fmaxf(mx, __shfl_xor(mx, 32));
    float sum = 0.f;
#pragma unroll
    for (int mt = 0; mt < 16; ++mt)
#pragma unroll
        for (int i = 0; i < 4; ++i) { const float p = __builtin_amdgcn_exp2f(s[mt][i] - mx); s[mt][i] = p; sum += p; }
    sum += __shfl_xor(sum, 16); sum += __shfl_xor(sum, 32);
    const float inv = 1.f / sum;
    bf16x8 pf[8];
#pragma unroll
    for (int k2 = 0; k2 < 8; ++k2) { u32x4 w; w.x = pk2(s[2 * k2][0], s[2 * k2][1]); w.y = pk2(s[2 * k2][2], s[2 * k2][3]); w.z = pk2(s[2 * k2 + 1][0], s[2 * k2 + 1][1]); w.w = pk2(s[2 * k2 + 1][2], s[2 * k2 + 1][3]); pf[k2] = __builtin_bit_cast(bf16x8, w); }
#pragma unroll 4
    for (int dt = 0; dt < 16; ++dt) {
        f32x4 o = {0.f, 0.f, 0.f, 0.f};
        const bf16_t* vr = Vt + (size_t)(h * 256 + 16 * dt + li) * 256 + 8 * g;
#pragma unroll
        for (int k2 = 0; k2 < 8; ++k2) o = mfma16(*(const bf16x8*)(vr + 32 * k2), pf[k2], o);
        o = o * inv; u32x2 w; w.x = pk2(o[0], o[1]); w.y = pk2(o[2], o[3]);
        *(u32x2*)(qrow + 16 * dt + 4 * g) = w;
    }
}

constexpr int AT_ST = 264;
static_assert(256 * AT_ST * 2 <= LDS_CTLOFF, "attention K/V tile fits below the LDS control words");
__device__ __forceinline__ void attn_unit_lds(LAS unsigned char* lds, bf16_t* MQ, const bf16_t* Kb, const bf16_t* Vt, int tblk, int h) {
    int tid_ = threadIdx.x; asm volatile("" : "+v"(tid_));
    const int tid = tid_, lane = tid & 63, wave = __builtin_amdgcn_readfirstlane(tid >> 6), g = lane >> 4, li = lane & 15;
    LAS bf16_t* T = (LAS bf16_t*)lds;
    u32x4 st[16];
#pragma unroll
    for (int i = 0; i < 16; ++i) { const int id = tid + 512 * i, row = id >> 5, cc = id & 31; st[i] = *(const u32x4*)(Kb + (size_t)row * 1024 + h * 256 + cc * 8); }
    bf16x8 qf[8];
    bf16_t* qrow = MQ + (size_t)(tblk + 16 * wave + li) * 1024 + h * 256;
#pragma unroll
    for (int ks = 0; ks < 8; ++ks) qf[ks] = *(const bf16x8*)(qrow + 32 * ks + 8 * g);
    __syncthreads();
#pragma unroll
    for (int i = 0; i < 16; ++i) { const int id = tid + 512 * i, row = id >> 5, cc = id & 31; *(LAS u32x4*)(T + row * AT_ST + cc * 8) = st[i]; }
#pragma unroll
    for (int i = 0; i < 16; ++i) { const int id = tid + 512 * i, row = id >> 5, cc = id & 31; st[i] = *(const u32x4*)(Vt + (size_t)(h * 256 + row) * 256 + cc * 8); }
    __syncthreads();
    f32x4 s[16];
#pragma unroll
    for (int mt = 0; mt < 16; ++mt) {
        s[mt] = (f32x4){0.f, 0.f, 0.f, 0.f};
        const LAS bf16_t* kr = T + (16 * mt + li) * AT_ST + 8 * g;
        bf16x8 kf[8];
#pragma unroll
        for (int ks = 0; ks < 8; ++ks) kf[ks] = *(const LAS bf16x8*)(kr + 32 * ks);
#pragma unroll
        for (int ks = 0; ks < 8; ++ks) s[mt] = mfma16(kf[ks], qf[ks], s[mt]);
    }
    float mx = -3.0e38f;
#pragma unroll
    for (int mt = 0; mt < 16; ++mt) mx = fmaxf(fmaxf(fmaxf(s[mt][0], s[mt][1]), fmaxf(s[mt][2], s[mt][3])), mx);
    mx = fmaxf(mx, __shfl_xor(mx, 16)); mx = fmaxf(mx, __shfl_xor(mx, 32));
    float sum = 0.f;
#pragma unroll
    for (int mt = 0; mt < 16; ++mt)
#pragma unroll
        for (int i = 0; i < 4; ++i) { const float p = __builtin_amdgcn_exp2f(s[mt][i] - mx); s[mt][i] = p; sum += p; }
    sum += __shfl_xor(sum, 16); sum += __shfl_xor(sum, 32);
    const float inv = 1.f / sum;
    bf16x8 pf[8];
#pragma unroll
    for (int k2 = 0; k2 < 8; ++k2) { u32x4 w; w.x = pk2(s[2 * k2][0], s[2 * k2][1]); w.y = pk2(s[2 * k2][2], s[2 * k2][3]); w.z = pk2(s[2 * k2 + 1][0], s[2 * k2 + 1][1]); w.w = pk2(s[2 * k2 + 1][2], s[2 * k2 + 1][3]); pf[k2] = __builtin_bit_cast(bf16x8, w); }
    __syncthreads();
#pragma unroll
    for (int i = 0; i < 16; ++i) { const int id = tid + 512 * i, row = id >> 5, cc = id & 31; *(LAS u32x4*)(T + row * AT_ST + cc * 8) = st[i]; }
    __syncthreads();
#pragma unroll 4
    for (int dt = 0; dt < 16; ++dt) {
        f32x4 o = {0.f, 0.f, 0.f, 0.f};
        const LAS bf16_t* vr = T + (16 * dt + li) * AT_ST + 8 * g;
        bf16x8 vf[8];
#pragma unroll
        for (int k2 = 0; k2 < 8; ++k2) vf[k2] = *(const LAS bf16x8*)(vr + 32 * k2);
#pragma unroll
        for (int k2 = 0; k2 < 8; ++k2) o = mfma16(vf[k2], pf[k2], o);
        o = o * inv; u32x2 w; w.x = pk2(o[0], o[1]); w.y = pk2(o[2], o[3]);
        *(u32x2*)(qrow + 16 * dt + 4 * g) = w;
    }
}

__device__ __forceinline__ void unpack8(const u32x4 w, float (&f)[8]) { f[0] = bflo(w.x); f[1] = bfhi(w.x); f[2] = bflo(w.y); f[3] = bfhi(w.y); f[4] = bflo(w.z); f[5] = bfhi(w.z); f[6] = bflo(w.w); f[7] = bfhi(w.w); }
__device__ __forceinline__ void load8f(const float* p, float (&f)[8]) { const f32x4 a = *(const f32x4*)p, b = *(const f32x4*)(p + 4); f[0] = a[0]; f[1] = a[1]; f[2] = a[2]; f[3] = a[3]; f[4] = b[0]; f[5] = b[1]; f[6] = b[2]; f[7] = b[3]; }
__device__ __forceinline__ void conv_item(int item, bf16_t* CB, const bf16_t* P, const float* wc, const float* st_s, float* outP, float* outS) {
    const int rg = item >> 7, c = (item & 127) * 8, r0 = rg * 8;
    float w0[8], w1[8], w2[8], h2[8], h1[8];
    load8f(wc + c, w0); load8f(wc + 1024 + c, w1); load8f(wc + 2048 + c, w2);
    if (tok_batch_start(r0)) {
        if (r0 < TP) {
#pragma unroll
            for (int k = 0; k < 8; ++k) { h2[k] = 0.f; h1[k] = 0.f; }
        } else { const float* sp = st_s + (size_t)((r0 - TP) >> 5) * 2048 + c; load8f(sp, h2); load8f(sp + 1024, h1); }
    } else { unpack8(*(const u32x4*)(P + (size_t)(r0 - 2) * 1024 + c), h2); unpack8(*(const u32x4*)(P + (size_t)(r0 - 1) * 1024 + c), h1); }
    u32x4 pw[8], bw[8];
#pragma unroll
    for (int i = 0; i < 8; ++i) { pw[i] = *(const u32x4*)(P + (size_t)(r0 + i) * 1024 + c); bw[i] = *(const u32x4*)(CB + (size_t)(r0 + i) * 1024 + c); }
#pragma unroll
    for (int i = 0; i < 8; ++i) {
        const int r = r0 + i; float p[8], b[8], y[8];
        unpack8(pw[i], p); unpack8(bw[i], b);
#pragma unroll
        for (int k = 0; k < 8; ++k) y[k] = b[k] * (w0[k] * h2[k] + w1[k] * h1[k] + w2[k] * p[k]);
        u32x4 o; o.x = pk2(y[0], y[1]); o.y = pk2(y[2], y[3]); o.z = pk2(y[4], y[5]); o.w = pk2(y[6], y[7]);
        *(u32x4*)(CB + (size_t)r * 1024 + c) = o;
        float* so = nullptr;
        if (r < TP) { const int t = r & 8191; if (t >= 8190) so = outP + ((size_t)(r >> 13) * 2 + (t - 8190)) * 1024; }
        else { const int t = (r - TP) & 31; if (t >= 30) so = outS + ((size_t)((r - TP) >> 5) * 2 + (t - 30)) * 1024; }
        if (so) { *(f32x4*)(so + c) = (f32x4){p[0], p[1], p[2], p[3]}; *(f32x4*)(so + c + 4) = (f32x4){p[4], p[5], p[6], p[7]}; }
#pragma unroll
        for (int k = 0; k < 8; ++k) { h2[k] = h1[k]; h1[k] = p[k]; }
    }
}
__device__ __forceinline__ void act_item(int item, const bf16_t* A, bf16_t* U, const float* wc, const float* st_s, bool do_store = true) {
    const int rg = item / 352, c = (item - rg * 352) * 8, r0 = rg * 8;
    float w0[8], w1[8], w2[8], h2[8], h1[8];
    load8f(wc + c, w0); load8f(wc + DFF + c, w1); load8f(wc + 2 * DFF + c, w2);
    if (tok_batch_start(r0)) {
        if (r0 < TP) {
#pragma unroll
            for (int k = 0; k < 8; ++k) { h2[k] = 0.f; h1[k] = 0.f; }
        } else { const float* sp = st_s + (size_t)((r0 - TP) >> 5) * 2 * DFF + c; load8f(sp, h2); load8f(sp + DFF, h1); }
    } else { unpack8(*(const u32x4*)(A + (size_t)(r0 - 2) * DFF + c), h2); unpack8(*(const u32x4*)(A + (size_t)(r0 - 1) * DFF + c), h1); }
    u32x4 aw[8], uw[8];
#pragma unroll
    for (int i = 0; i < 8; ++i) { aw[i] = *(const u32x4*)(A + (size_t)(r0 + i) * DFF + c); uw[i] = *(const u32x4*)(U + (size_t)(r0 + i) * DFF + c); }
#pragma unroll
    for (int i = 0; i < 8; ++i) {
        float a[8], u[8], y[8];
        unpack8(aw[i], a); unpack8(uw[i], u);
#pragma unroll
        for (int k = 0; k < 8; ++k) y[k] = silu_f(w0[k] * h2[k] + w1[k] * h1[k] + w2[k] * a[k]) * u[k];
        u32x4 o; o.x = pk2(y[0], y[1]); o.y = pk2(y[2], y[3]); o.z = pk2(y[4], y[5]); o.w = pk2(y[6], y[7]);
        if (do_store) *(u32x4*)(U + (size_t)(r0 + i) * DFF + c) = o;
#pragma unroll
        for (int k = 0; k < 8; ++k) { h2[k] = h1[k]; h1[k] = a[k]; }
    }
}

__device__ __forceinline__ f32x4 skinny_gemm(LAS unsigned char* lds, const bf16_t* Act, int K, const bf16_t* Wt, int n0, int rq, int wave, int lane_) {
    int lane = lane_; asm volatile("" : "+v"(lane));
    const int g = lane >> 4, li = lane & 15, K8 = K >> 3, nk = K8 >> 5;
    const bf16_t* wp = Wt + (size_t)(n0 + li) * K + wave * K8 + 8 * g;
    const bf16_t* ap = Act + (size_t)(64 * rq + li) * K + wave * K8 + 8 * g;
    f32x4 acc[4];
#pragma unroll
    for (int t = 0; t < 4; ++t) acc[t] = (f32x4){0.f, 0.f, 0.f, 0.f};
    for (int k0 = 0; k0 < nk; k0 += 4) {
        bf16x8 wf[4], xf[4][4];
#pragma unroll
        for (int j = 0; j < 4; ++j) if (k0 + j < nk) {
            wf[j] = *(const bf16x8*)(wp + 32 * (k0 + j));
#pragma unroll
            for (int t = 0; t < 4; ++t) xf[j][t] = *(const bf16x8*)(ap + (size_t)(16 * t) * K + 32 * (k0 + j));
        }
#pragma unroll
        for (int j = 0; j < 4; ++j) if (k0 + j < nk) {
#pragma unroll
            for (int t = 0; t < 4; ++t) acc[t] = mfma16(wf[j], xf[j][t], acc[t]);
        }
    }
    LAS f32x4* xch = (LAS f32x4*)(lds + 65536);
    __syncthreads();
#pragma unroll
    for (int t = 0; t < 4; ++t) xch[(wave * 4 + t) * 64 + lane] = acc[t];
    __syncthreads();
    f32x4 r = {0.f, 0.f, 0.f, 0.f};
    if (wave < 4) {
#pragma unroll
        for (int w = 0; w < 8; ++w) r = r + xch[(w * 4 + wave) * 64 + lane];
    }
    return r;
}
#define XB_TMO      128
#define XB_XCNT(j)  (256  + 64 * (j))
#define XB_XSUB(j)  (1280 + 64 * (j))
#define XB_XGEN(j)  (2304 + 64 * (j))
#define XB_TOP      3328
#define XB_TOPGEN   3392
#define XCD_BAR_WORDS 3456
#define XB_SPIN_CAP (1u << 18)

__device__ __forceinline__ unsigned xb_ld(unsigned* p)              { return __hip_atomic_load(p, __ATOMIC_RELAXED, __HIP_MEMORY_SCOPE_AGENT); }
__device__ __forceinline__ unsigned xb_add(unsigned* p, unsigned v) { return __hip_atomic_fetch_add(p, v, __ATOMIC_RELAXED, __HIP_MEMORY_SCOPE_AGENT); }
__device__ __forceinline__ unsigned xb_xcc_id() { return (unsigned)__builtin_amdgcn_s_getreg((3 << 11) | 20) & 0xFu; }
#define XB_SPIN(cond, bar) do { unsigned _sp = 0; while (cond) { __builtin_amdgcn_s_sleep(1); \
    if ((++_sp & 255u) == 0u) { if (xb_ld(&(bar)[XB_TMO])) break; if (_sp > XB_SPIN_CAP) { atomicAdd(&(bar)[XB_TMO], 1u); break; } } } } while (0)

struct XcdBarrier {
    unsigned* bar; unsigned x;
    volatile __attribute__((address_space(3))) unsigned* st;
};

__device__ __forceinline__ XcdBarrier xcd_barrier_post(unsigned* bar, volatile __attribute__((address_space(3))) unsigned* st) {
    XcdBarrier b; b.bar = bar; b.x = xb_xcc_id(); b.st = st;
    if (threadIdx.x == 0) (void)xb_add(&bar[XB_XCNT(b.x)], 1u);
    return b;
}
__device__ __forceinline__ void xcd_barrier_complete(unsigned* bar, unsigned x, unsigned& nloc, unsigned& nx) {
    const unsigned G = gridDim.x * gridDim.y * gridDim.z;
    unsigned sum, cnt, mine, sp = 0u;
    for (;;) {
        sum = 0u; cnt = 0u; mine = 0u;
#pragma unroll
        for (unsigned j = 0; j < 16; ++j) { const unsigned c = xb_ld(&bar[XB_XCNT(j)]); sum += c; cnt += (c > 0u) ? 1u : 0u; mine = (j == x) ? c : mine; }
        if (sum == G) break;
        __builtin_amdgcn_s_sleep(1);
        if ((++sp & 255u) == 0u) { if (xb_ld(&bar[XB_TMO])) break; if (sp > XB_SPIN_CAP) { atomicAdd(&bar[XB_TMO], 1u); break; } }
    }
    nloc = mine > 0u ? mine : 1u; nx = cnt > 0u ? cnt : 1u;
}

__device__ __forceinline__ void xcd_barrier(const XcdBarrier& b) {
    asm volatile("s_waitcnt vmcnt(0)" ::: "memory");
    __syncthreads();
    if (threadIdx.x == 0) {
        unsigned* bar = b.bar;
        __builtin_amdgcn_s_waitcnt(0);
        unsigned nloc = b.st[0], nx = b.st[1];
        if (nloc == 0u) { xcd_barrier_complete(bar, b.x, nloc, nx); b.st[0] = nloc; b.st[1] = nx; }
        const unsigned old = xb_add(&bar[XB_XSUB(b.x)], 1u);
        const unsigned gen = old / nloc;
        if (old + 1u == (gen + 1u) * nloc) {
            __builtin_amdgcn_fence(__ATOMIC_RELEASE, "agent");
            asm volatile("s_waitcnt vmcnt(0)" ::: "memory");
            const unsigned og = xb_add(&bar[XB_TOP], 1u);
            const unsigned tg = og / nx;
            if (og + 1u == (tg + 1u) * nx) xb_add(&bar[XB_TOPGEN], 1u);
            else XB_SPIN(xb_ld(&bar[XB_TOPGEN]) == tg, bar);
            __builtin_amdgcn_fence(__ATOMIC_ACQUIRE, "agent");
            xb_add(&bar[XB_XGEN(b.x)], 1u);
            asm volatile("s_waitcnt vmcnt(0)" ::: "memory");
        } else {
            XB_SPIN(xb_ld(&bar[XB_XGEN(b.x)]) == gen, bar);
            __builtin_amdgcn_fence(__ATOMIC_ACQUIRE, "agent");
            asm volatile("s_waitcnt vmcnt(0)" ::: "memory");
        }
    }
    __syncthreads();
}

__global__ void __launch_bounds__(512, 2) fwd_megakernel(Args args) {
    extern __shared__ __attribute__((aligned(16))) unsigned char lds_raw[];
    LAS unsigned char* lds = (LAS unsigned char*)lds_raw;
    cg::grid_group grid = cg::this_grid();
    { volatile LAS unsigned* z = (volatile LAS unsigned*)(lds + LDS_CTLOFF); if (threadIdx.x < 16) z[threadIdx.x] = 0u; __syncthreads(); }
    if (args.out == nullptr) grid.sync();
    const XcdBarrier xbar = xcd_barrier_post((unsigned*)(args.ws + WS_CTL + CTL_XBAR), (volatile LAS unsigned*)(lds + LDS_CTLOFF + 16));
    const int G = gridDim.x, blk = blockIdx.x, NGW = G * 8;
#define PHASE_IDS() int tid_ = threadIdx.x; asm volatile("" : "+v"(tid_)); const int tid = tid_, lane = tid & 63, wave = __builtin_amdgcn_readfirstlane(tid >> 6), gw = blk * 8 + wave; (void)gw; (void)lane; (void)tid
    unsigned char* ws = args.ws; float* out = args.out;
    const float* x_prompt = args.in[0]; const float* x_sample = args.in[1]; const float* mem_prompt = args.in[2]; const float* state_ret = args.in[3];
    const float* state_conv = args.in[4]; const float* state_ffn = args.in[5]; const float* cache_k = args.in[6]; const float* cache_v = args.in[7];
    const float* g_mix = args.in[8]; const float* w_in = args.in[9]; const float* g_ret_gn = args.in[10]; const float* w_conv = args.in[11]; const float* g_mem = args.in[12];
    const float* w_mem_kv = args.in[13]; const float* w_br_ret = args.in[14]; const float* w_br_conv = args.in[15]; const float* w_br_mem = args.in[16]; const float* w_out = args.in[17];
    const float* g_ffn = args.in[18]; const float* w_ffn_in = args.in[19]; const float* w_ffn_conv = args.in[20]; const float* w_ffn_down = args.in[21]; const float* g_final = args.in[22];
    bf16_t* FFNIN = (bf16_t*)(ws + WS_FFNIN); bf16_t* FFNDN = (bf16_t*)(ws + WS_FFNDN); bf16_t* WOUT = (bf16_t*)(ws + WS_WOUT); bf16_t* BRRET = (bf16_t*)(ws + WS_BRRET);
    bf16_t* BRCONV = (bf16_t*)(ws + WS_BRCONV); bf16_t* BRMEM = (bf16_t*)(ws + WS_BRMEM); bf16_t* WIN = (bf16_t*)(ws + WS_WIN); bf16_t* WMEMKV = (bf16_t*)(ws + WS_WMEMKV);
    bf16_t* HN = (bf16_t*)(ws + WS_HN); bf16_t* Vb = (bf16_t*)(ws + WS_V); bf16_t* CB = (bf16_t*)(ws + WS_CB); bf16_t* Pb = (bf16_t*)(ws + WS_P); bf16_t* MQ = (bf16_t*)(ws + WS_MQ);
    bf16_t* MKB = (bf16_t*)(ws + WS_MKB); bf16_t* MVT = (bf16_t*)(ws + WS_MVT); bf16_t* MERGED = (bf16_t*)(ws + WS_MERGED);
    bf16_t* X1B = (bf16_t*)(ws + WS_X1B); bf16_t* ABUF = (bf16_t*)(ws + WS_ABUF); bf16_t* UBUF = (bf16_t*)(ws + WS_UBUF);
    unsigned* queue = (unsigned*)(ws + WS_CTL + CTL_QUEUE); float* SS1 = (float*)(ws + WS_CTL + CTL_SS1); float* SS2 = (float*)(ws + WS_CTL + CTL_SS2); float* STAT = (float*)(ws + WS_CTL + CTL_STAT);
    bf16_t* QK = (bf16_t*)out;
    bf16_t* ORNB = (bf16_t*)out; bf16_t* STASH = Vb; float* X1 = out + O_Y;
    bf16_t* MEMN = (bf16_t*)(out + O_RETS);

    for (int rep_ = 0; rep_ < REP_P0; ++rep_)
    {
        PHASE_IDS(); LAS float* scr = (LAS float*)(lds + wave * 16384);
        constexpr int I_WIN = 16 * 416, I_MKV = 16 * 64, I_RET = 32 * 32, I_SQ = 16 * 32, I_CV = 8 * 4 * 32;
        constexpr int NIT = I_WIN + I_MKV + I_RET + 3 * I_SQ + I_CV;
        for (int it = gw; it < NIT; it += NGW) {
            int r = it;
            if (r < I_WIN) { const int kb = r / 416, nb = r % 416; transpose_item<false>(w_in, 13312, WIN, 1024, 64 * kb, 32 * nb, map_win(32 * nb), nullptr, scr, lane); continue; } r -= I_WIN;
            if (r < I_MKV) { const int kb = r / 64, nb = r % 64; transpose_item<false>(w_mem_kv, 2048, WMEMKV, 1024, 64 * kb, 32 * nb, 32 * nb, nullptr, scr, lane); continue; } r -= I_MKV;
            if (r < I_RET) { const int kb = r / 32, nb = r % 32; transpose_item<false>(w_br_ret, 1024, BRRET, 2048, 64 * kb, 32 * nb, 32 * nb, nullptr, scr, lane); continue; } r -= I_RET;
            if (r < I_SQ) { const int kb = r / 32, nb = r % 32; transpose_item<false>(w_br_conv, 1024, BRCONV, 1024, 64 * kb, 32 * nb, 32 * nb, nullptr, scr, lane); continue; } r -= I_SQ;
            if (r < I_SQ) { const int kb = r / 32, nb = r % 32; transpose_item<false>(w_br_mem, 1024, BRMEM, 1024, 64 * kb, 32 * nb, 32 * nb, nullptr, scr, lane); continue; } r -= I_SQ;
            if (r < I_SQ) { const int kb = r / 32, nb = r % 32; transpose_item<false>(w_out, 1024, WOUT, 1024, 64 * kb, 32 * nb, 32 * nb, nullptr, scr, lane); continue; } r -= I_SQ;
            { const int b = r / 128, q = r % 128, kb = q / 32, nb = q % 32;
              transpose_item<true>(cache_v + (size_t)b * 262144, 1024, MVT + (size_t)(2 + b) * 262144, 256, 64 * kb, 32 * nb, 32 * nb, nullptr, scr, lane); }
        }
        for (int m = gw; m < T; m += 2 * NGW) {
            const int m2 = m + NGW; const bool two = m2 < T;
            const float* xa = m < TP ? x_prompt + (size_t)m * 1024 : x_sample + (size_t)(m - TP) * 1024;
            const float* xb = !two ? xa : (m2 < TP ? x_prompt + (size_t)m2 * 1024 : x_sample + (size_t)(m2 - TP) * 1024);
            f32x4 va[4], vb[4]; float sa = 0.f, sb = 0.f;
#pragma unroll
            for (int j = 0; j < 4; ++j) { va[j] = ((const f32x4*)xa)[lane + 64 * j]; vb[j] = ((const f32x4*)xb)[lane + 64 * j]; }
#pragma unroll
            for (int j = 0; j < 4; ++j) { sa += (va[j][0] * va[j][0] + va[j][1] * va[j][1]) + (va[j][2] * va[j][2] + va[j][3] * va[j][3]); sb += (vb[j][0] * vb[j][0] + vb[j][1] * vb[j][1]) + (vb[j][2] * vb[j][2] + vb[j][3] * vb[j][3]); }
            const float ra = rsqrtf(wave_sum(sa) * (1.f / 1024.f) + EPS), rb = rsqrtf(wave_sum(sb) * (1.f / 1024.f) + EPS);
#pragma unroll
            for (int j = 0; j < 4; ++j) { const f32x4 gg = ((const f32x4*)g_mix)[lane + 64 * j];
                u32x2 w; w.x = pk2(va[j][0] * ra * gg[0], va[j][1] * ra * gg[1]); w.y = pk2(va[j][2] * ra * gg[2], va[j][3] * ra * gg[3]); ((u32x2*)(HN + (size_t)m * 1024))[lane + 64 * j] = w;
                if (two) { u32x2 w2; w2.x = pk2(vb[j][0] * rb * gg[0], vb[j][1] * rb * gg[1]); w2.y = pk2(vb[j][2] * rb * gg[2], vb[j][3] * rb * gg[3]); ((u32x2*)(HN + (size_t)m2 * 1024))[lane + 64 * j] = w2; } }
        }
        for (int m = gw; m < 512; m += NGW) row_norm_bf16(mem_prompt + (size_t)m * 1024, g_mem, MEMN + (size_t)m * 1024, lane, true);
        for (int m = gw; m < 2048; m += NGW) row_norm_bf16(cache_k + (size_t)m * 1024, nullptr, MKB + (size_t)(512 + m) * 1024, lane, false);
    }
    xcd_barrier(xbar);

#ifndef SCAN_PROBE_MODE
#define SCAN_PROBE_MODE 0
#endif
#ifndef REP_SK3
#define REP_SK3 1
#endif
#ifndef XBAR_TWICE
#define XBAR_TWICE 0
#endif
#ifndef REP_P12
#define REP_P12 0
#endif
#ifndef P2_MASK_FIRST
#define P2_MASK_FIRST 15
#endif
    for (int rep12_ = 0; rep12_ <= REP_P12; ++rep12_) {
    if (rep12_) { PHASE_IDS(); for (int i_ = blk * 512 + tid; i_ < T * 8; i_ += G * 512) STAT[i_] = 0.f; if (blk == 0 && tid < 3) queue[64 * tid] = 0u; xcd_barrier(xbar); }
#ifndef SKIP_P1
    for (int rep_ = 0; rep_ < REP_P1; ++rep_)
    {
        pg8::Gemm g{HN, WIN, T, 8192, 1024}; pg8::StaticOrder S; S.init(T, 8192, G, blk);
        EpiZ1a E{QK, Vb, CB, Pb, MQ};
        pg8::gemm_phase<EpiZ1a, pg8::StaticOrder, true, true>(lds, g, S, E);
        if (rep12_ == 0) {
        pg8::Gemm g2{MEMN, WMEMKV, 512, 2048, 1024}; pg8::StaticOrder S2; S2.init(512, 2048, G, (blk + G - 32) % G);
        EpiMemKV E2{out + O_MKP, out + O_MVP, MKB, MVT};
        pg8::gemm_phase<EpiMemKV, pg8::StaticOrder, true, true>(lds, g2, S2, E2);
        }
    }
#endif
    xcd_barrier(xbar); if (XBAR_TWICE) xcd_barrier(xbar);

#ifndef SKIP_P2
    {
        PHASE_IDS();
        LAS volatile int* qs = (LAS volatile int*)(lds + LDS_CTLOFF);
        constexpr int U_SCANP = 128, U_SCANS = 512, U_ATT = 520, U_CONV = 520;
#define QUEUE_NEXT(word, uu) do { if (tid == 0) *qs = (int)atomicAdd(queue + (word), 1u); __syncthreads(); uu = *qs; __syncthreads(); } while (0)
        for (;;) {
            int uu; QUEUE_NEXT(0, uu);
            if (uu >= U_SCANP + U_SCANS) break;
            if (REP_P12 && rep12_ == 0 && !((P2_MASK_FIRST >> (uu < U_SCANP ? 0 : 1)) & 1)) continue;
            int row0, nch, h, es; const float* S0; float* So;
            if (uu < U_SCANP) { const int bh = uu >> 4; es = uu & 15; h = bh & 3; row0 = (bh >> 2) * 8192; nch = 256; S0 = nullptr; So = out + O_RETP + (size_t)bh * 131072; }
            else { const int v = uu - U_SCANP, bh = v >> 4; es = v & 15; h = bh & 3; row0 = TP + (bh >> 2) * 32; nch = 1; S0 = state_ret + (size_t)bh * 131072; So = out + O_RETS + (size_t)bh * 131072; }
            const float log2g = log2f(1.f - exp2f(-5.f - (float)h));
            { int pm_ = 0; if (REP_P12 && rep12_ == 0) { pm_ = SCAN_PROBE_MODE & 7; if (SCAN_PROBE_MODE & 8) nch = nch > 1 ? nch / 2 : 1; }
              scan_unit(lds, QK, Vb, STAT, row0, nch, h, es, S0, So, log2g, pm_); }
        }
        for (;;) {
            int uu; QUEUE_NEXT(64, uu);
            if (uu >= U_ATT) break;
            if (REP_P12 && rep12_ == 0 && !((P2_MASK_FIRST >> 2) & 1)) continue;
            const int tile = uu >> 2, h = uu & 3, t0 = tile * 128 + wave * 16;
            const int bb = t0 < TP ? (t0 >> 13) : 2 + ((t0 - TP) >> 5);
            if (tile < 128) attn_unit_lds(lds, MQ, MKB + (size_t)bb * 262144, MVT + (size_t)bb * 262144, tile * 128, h);
            else attn_wave(MQ, MKB + (size_t)bb * 262144, MVT + (size_t)bb * 262144, t0, h, lane);
        }
        for (;;) {
            int uu; QUEUE_NEXT(128, uu);
            if (uu >= U_CONV) break;
            if (REP_P12 && rep12_ == 0 && !((P2_MASK_FIRST >> 3) & 1)) continue;
            { int t2 = tid; asm volatile("" : "+v"(t2)); conv_item(uu * 512 + t2, CB, Pb, w_conv, state_conv, out + O_CONVP, out + O_CONVS); }
        }
#undef QUEUE_NEXT
    }
#endif
    xcd_barrier(xbar); if (XBAR_TWICE) xcd_barrier(xbar);

    }
#ifdef PROBE_P2B
    { PHASE_IDS(); LAS float* scr = (LAS float*)(lds + wave * 16384);
      for (int it = gw; it < 16 * 176 + 44 * 32; it += NGW) {
            if (it < 16 * 176) { const int kb = it / 176, nb = it % 176; transpose_item<false>(w_ffn_in, 5632, FFNIN, 1024, 64 * kb, 32 * nb, map_ffn(32 * nb), g_ffn, scr, lane); }
            else { const int r = it - 16 * 176, kb = r / 32, nb = r % 32; transpose_item<false>(w_ffn_down, 1024, FFNDN, DFF, 64 * kb, 32 * nb, 32 * nb, nullptr, scr, lane); } }
      __syncthreads();
      pg8::Gemm g{HN, WIN + (size_t)8192 * 1024, T, 2048, 1024}; pg8::StaticOrder S; S.init(T, 2048, G, blk); EpiNull E{queue + 200, SS2};
      pg8::gemm_phase<EpiNull, pg8::StaticOrder, true, true>(lds, g, S, E); }
#endif
#ifndef SKIP_P2B
    {
        PHASE_IDS(); LAS float* scr = (LAS float*)(lds + wave * 16384);
        constexpr int I_FIN = 16 * 176, I_FDN = 44 * 32;
        for (int it = gw; it < I_FIN + I_FDN; it += NGW) {
            if (it < I_FIN) { const int kb = it / 176, nb = it % 176; transpose_item<false>(w_ffn_in, 5632, FFNIN, 1024, 64 * kb, 32 * nb, map_ffn(32 * nb), g_ffn, scr, lane); }
            else { const int r = it - I_FIN, kb = r / 32, nb = r % 32; transpose_item<false>(w_ffn_down, 1024, FFNDN, DFF, 64 * kb, 32 * nb, 32 * nb, nullptr, scr, lane); }
        }
        for (int pc_ = blk; pc_ < 512; pc_ += G) {
            const int strip = (pc_ & 7) + 8 * (pc_ >> 5), n0 = 16 * strip, rq = (pc_ >> 3) & 3, h_ = strip >> 5,
            g4 = lane >> 4, li = lane & 15;
            LAS float* sst = (LAS float*)(lds + 32768);
            __syncthreads();
            {
                u32x4 w_[8];
#pragma unroll
                for (int k8 = 0; k8 < 8; ++k8) w_[k8] = *(const u32x4*)(Vb + (size_t)(TP + 64 * rq + wave + 8 * k8) * 2048 + h_ * 512 + lane * 8);
#pragma unroll
                for (int k8 = 0; k8 < 8; ++k8) {
                    const int rr_ = wave + 8 * k8;
                    const float a0_ = bflo(w_[k8].x), a1_ = bfhi(w_[k8].x), a2_ = bflo(w_[k8].y), a3_ = bfhi(w_[k8].y), a4_ = bflo(w_[k8].z), a5_ = bfhi(w_[k8].z), a6_ = bflo(w_[k8].w), a7_ = bfhi(w_[k8].w);
                    float s1_ = ((a0_ + a1_) + (a2_ + a3_)) + ((a4_ + a5_) + (a6_ + a7_)), s2_ = ((a0_ * a0_ + a1_ * a1_) + (a2_ * a2_ + a3_ * a3_)) + ((a4_ * a4_ + a5_ * a5_) + (a6_ * a6_ + a7_ * a7_));
                    s1_ = wave_sum(s1_); s2_ = wave_sum(s2_);
                    if (lane == 0) { sst[2 * rr_] = s1_; sst[2 * rr_ + 1] = s2_; }
                }
            }
            const f32x4 ac = skinny_gemm(lds, HN + (size_t)TP * 1024, 1024, WIN + (size_t)8192 * 1024, n0, rq, wave, lane);
            if (wave < 4) {
                const int rl = 16 * wave + li; const size_t po = (size_t)(TP + 64 * rq + rl) * 2048 + n0 + 4 * g4;
                const float mu = sst[2 * rl] * (1.f / 512.f), var = fmaxf(sst[2 * rl + 1] * (1.f / 512.f) - mu * mu, 0.f), rstd = rsqrtf(var + EPS);
                const u32x2 ov = *(const u32x2*)(Vb + po); const f32x4 gv = *(const f32x4*)(g_ret_gn + n0 + 4 * g4);
                const float o0 = bflo(ov.x), o1 = bfhi(ov.x), o2 = bflo(ov.y), o3 = bfhi(ov.y);
                u32x2 w; w.x = pk2((o0 - mu) * rstd * gv[0] * silu_f(ac[0]), (o1 - mu) * rstd * gv[1] * silu_f(ac[1])); w.y = pk2((o2 - mu) * rstd * gv[2] * silu_f(ac[2]), (o3 - mu) * rstd * gv[3] * silu_f(ac[3]));
                *(u32x2*)(ORNB + po) = w;
            }
        }
        __syncthreads();
        pg8::StaticOrder S; S.init(TP, 2048, G, blk);
        {
            Unit u_;
            for (int i_ = 0; S.next(i_, u_); ++i_) {
                const int h_ = u_.pn >> 1;
                for (int rb_ = 0; rb_ < 32; rb_ += 8) {
                    u32x4 w_[8];
#pragma unroll
                    for (int k8 = 0; k8 < 8; ++k8) w_[k8] = *(const u32x4*)(Vb + (size_t)(u_.pm * 256 + wave + 8 * (rb_ + k8)) * 2048 + h_ * 512 + lane * 8);
#pragma unroll
                    for (int k8 = 0; k8 < 8; ++k8) {
                        const int r_ = u_.pm * 256 + wave + 8 * (rb_ + k8);
                        const float a0_ = bflo(w_[k8].x), a1_ = bfhi(w_[k8].x), a2_ = bflo(w_[k8].y), a3_ = bfhi(w_[k8].y), a4_ = bflo(w_[k8].z), a5_ = bfhi(w_[k8].z), a6_ = bflo(w_[k8].w), a7_ = bfhi(w_[k8].w);
                        float s1_ = ((a0_ + a1_) + (a2_ + a3_)) + ((a4_ + a5_) + (a6_ + a7_)), s2_ = ((a0_ * a0_ + a1_ * a1_) + (a2_ * a2_ + a3_ * a3_)) + ((a4_ * a4_ + a5_ * a5_) + (a6_ * a6_ + a7_ * a7_));
                        s1_ = wave_sum(s1_); s2_ = wave_sum(s2_);
                        if (lane == 0) { STAT[(size_t)r_ * 8 + 2 * h_] = s1_; STAT[(size_t)r_ * 8 + 2 * h_ + 1] = s2_; }
                    }
                }
            }
            __threadfence_block();
        }
        __syncthreads();
        pg8::Gemm g{HN, WIN + (size_t)8192 * 1024, TP, 2048, 1024};
        EpiGR E{Vb, ORNB, STAT, g_ret_gn};
        pg8::gemm_phase<EpiGR, pg8::StaticOrder, true, true>(lds, g, S, E);
    }
#endif
    xcd_barrier(xbar); if (XBAR_TWICE) xcd_barrier(xbar);

#ifndef SKIP_P3
    for (int rep_ = 0; rep_ < REP_P3; ++rep_)
    {
        {
            PHASE_IDS(); for (int rsk_ = 0; rsk_ < REP_SK3; ++rsk_) for (int pc_ = blk; pc_ < 256; pc_ += G) { const int n0 = 16 * ((pc_ & 7) + 8 * (pc_ >> 5)), rq = (pc_ >> 3) & 3, g4 = lane >> 4, li = lane & 15;
            const bf16_t* HNs = HN + (size_t)TP * 1024;
            f32x4 gt = skinny_gemm(lds, HNs, 1024, WIN + (size_t)10240 * 1024, n0, rq, wave, lane), br = skinny_gemm(lds, ORNB + (size_t)TP * 2048, 2048, BRRET, n0, rq, wave, lane), mg;
#pragma unroll
            for (int i = 0; i < 4; ++i) mg[i] = sigm_f(gt[i]) * br[i];
            gt = skinny_gemm(lds, HNs, 1024, WIN + (size_t)11264 * 1024, n0, rq, wave, lane); br = skinny_gemm(lds, CB + (size_t)TP * 1024, 1024, BRCONV, n0, rq, wave, lane);
#pragma unroll
            for (int i = 0; i < 4; ++i) mg[i] += sigm_f(gt[i]) * br[i];
            gt = skinny_gemm(lds, HNs, 1024, WIN + (size_t)12288 * 1024, n0, rq, wave, lane); br = skinny_gemm(lds, MQ + (size_t)TP * 1024, 1024, BRMEM, n0, rq, wave, lane);
#pragma unroll
            for (int i = 0; i < 4; ++i) mg[i] += sigm_f(gt[i]) * br[i];
            if (wave < 4) { u32x2 w; w.x = pk2(mg[0], mg[1]); w.y = pk2(mg[2], mg[3]); *(u32x2*)(MERGED + (size_t)(TP + 64 * rq + 16 * wave + li) * 1024 + n0 + 4 * g4) = w; }
            __syncthreads(); }
        }
        pg8::StaticOrder S; S.init(TP, 1024, G, blk);
        EpiGate EG{STASH};
        { pg8::Gemm g{HN, WIN + (size_t)10240 * 1024, TP, 1024, 1024}; pg8::gemm_phase<EpiGate, pg8::StaticOrder, true, true>(lds, g, S, EG); }
        { pg8::Gemm g{ORNB, BRRET, TP, 1024, 2048}; EpiBranch<true> E{STASH, MERGED}; pg8::gemm_phase<EpiBranch<true>, pg8::StaticOrder, true, true>(lds, g, S, E); }
        { pg8::Gemm g{HN, WIN + (size_t)11264 * 1024, TP, 1024, 1024}; pg8::gemm_phase<EpiGate, pg8::StaticOrder, true, true>(lds, g, S, EG); }
        { pg8::Gemm g{CB, BRCONV, TP, 1024, 1024}; EpiBranch<false> E{STASH, MERGED}; pg8::gemm_phase<EpiBranch<false>, pg8::StaticOrder, true, true>(lds, g, S, E); }
        { pg8::Gemm g{HN, WIN + (size_t)12288 * 1024, TP, 1024, 1024}; pg8::gemm_phase<EpiGate, pg8::StaticOrder, true, true>(lds, g, S, EG); }
        { pg8::Gemm g{MQ, BRMEM, TP, 1024, 1024}; EpiBranch<false> E{STASH, MERGED}; pg8::gemm_phase<EpiBranch<false>, pg8::StaticOrder, true, true>(lds, g, S, E); }
    }
#endif
    xcd_barrier(xbar); if (XBAR_TWICE) xcd_barrier(xbar);

#ifdef PROBE_P4
    { pg8::Gemm g{MERGED, WOUT, TP, 1024, 1024}; pg8::StaticOrder S; S.init(TP, 1024, G, blk); EpiNull E{queue + 200, SS2};
      pg8::gemm_phase<EpiNull, pg8::StaticOrder, true, true>(lds, g, S, E); }
#endif
#ifndef SKIP_P4
    {
        {
            PHASE_IDS(); for (int pc_ = blk; pc_ < 256; pc_ += G) { const int n0 = 16 * ((pc_ & 7) + 8 * (pc_ >> 5)), rq = (pc_ >> 3) & 3, g4 = lane >> 4, li = lane & 15;
            const f32x4 ac = skinny_gemm(lds, MERGED + (size_t)TP * 1024, 1024, WOUT, n0, rq, wave, lane);
            if (wave < 4) {
                const int rs_ = 64 * rq + 16 * wave + li; const size_t off = (size_t)(TP + rs_) * 1024 + n0 + 4 * g4;
                const f32x4 v = *(const f32x4*)(x_sample + (size_t)rs_ * 1024 + n0 + 4 * g4) + ac;
                *(f32x4*)(X1 + off) = v; u32x2 w; w.x = pk2(v[0], v[1]); w.y = pk2(v[2], v[3]); *(u32x2*)(X1B + off) = w;
                float q = (v[0] * v[0] + v[1] * v[1]) + (v[2] * v[2] + v[3] * v[3]); q += __shfl_xor(q, 16); q += __shfl_xor(q, 32);
                if (g4 == 0) atomicAdd(SS1 + TP + rs_, q);
            }
            __syncthreads(); }
        }
        pg8::Gemm g{MERGED, WOUT, TP, 1024, 1024}; pg8::StaticOrder S; S.init(TP, 1024, G, blk);
        EpiRes<true> E{x_prompt, x_sample, X1, X1B, SS1};
        pg8::gemm_phase<EpiRes<true>, pg8::StaticOrder, true, true>(lds, g, S, E);
    }
#endif
    xcd_barrier(xbar); if (XBAR_TWICE) xcd_barrier(xbar);

#ifndef SKIP_P5
    for (int rep_ = 0; rep_ < REP_P5; ++rep_)
    {
        pg8::Gemm g{X1B, FFNIN, T, 5632, 1024}; pg8::StaticOrder S; S.init(T, 5632, G, blk);
        EpiUp E{ABUF, UBUF, SS1, out + O_FFNP, out + O_FFNS};
        pg8::gemm_phase<EpiUp, pg8::StaticOrder, true, true>(lds, g, S, E);
    }
#endif
    xcd_barrier(xbar); if (XBAR_TWICE) xcd_barrier(xbar);

#ifdef PROBE_P5B
    { PHASE_IDS(); const bool dz = queue[200] == 12345u;
      for (int it = blk * 512 + tid; it < 2080 * 352; it += G * 512) act_item(it, ABUF, UBUF, w_ffn_conv, state_ffn, dz); }
#endif
#ifndef SKIP_P5B
    { PHASE_IDS();
      for (int it = blk * 512 + tid; it < 2080 * 352; it += G * 512) act_item(it, ABUF, UBUF, w_ffn_conv, state_ffn); }
#endif
    xcd_barrier(xbar); if (XBAR_TWICE) xcd_barrier(xbar);

#ifdef PROBE_P6
    { pg8::Gemm g{UBUF, FFNDN, TP, 1024, DFF}; pg8::StaticOrder S; S.init(TP, 1024, G, blk); EpiNull E{queue + 200, SS1};
      pg8::gemm_phase<EpiNull, pg8::StaticOrder, true, true>(lds, g, S, E); }
#endif
#ifndef SKIP_P6
    {
        unsigned* fincnt = (unsigned*)(ws + WS_CTL + CTL_FIN);
        const bool fusedfin = (G == 256);
        {
            PHASE_IDS(); for (int pc_ = blk; pc_ < 256; pc_ += G) { const int n0 = 16 * ((pc_ & 7) + 8 * (pc_ >> 5)), rq = (pc_ >> 3) & 3, g4 = lane >> 4, li = lane & 15;
            const f32x4 ac = skinny_gemm(lds, UBUF + (size_t)TP * DFF, DFF, FFNDN, n0, rq, wave, lane);
            const int rs_ = 64 * rq + 16 * (wave & 3) + li; const size_t off = (size_t)(TP + rs_) * 1024 + n0 + 4 * g4;
            f32x4 v = {0.f, 0.f, 0.f, 0.f};
            if (wave < 4) {
                v = *(const f32x4*)(X1 + off) + ac;
                if (!fusedfin) *(f32x4*)(X1 + off) = v;
                float q = (v[0] * v[0] + v[1] * v[1]) + (v[2] * v[2] + v[3] * v[3]); q += __shfl_xor(q, 16); q += __shfl_xor(q, 32);
                if (g4 == 0) atomicAdd(SS2 + TP + rs_, q);
            }
            if (fusedfin) {
                panel_arrive_and_wait(fincnt + 16 * (64 + rq), 64u);
                if (wave < 4) { const float rs = rsqrtf(ld_agent_f(SS2 + TP + rs_) * (1.f / 1024.f) + EPS); *(f32x4*)(X1 + off) = v * rs * *(const f32x4*)(g_final + n0 + 4 * g4); }
            }
            __syncthreads(); }
        }
        pg8::Gemm g{UBUF, FFNDN, TP, 1024, DFF}; pg8::StaticOrder S; S.init(TP, 1024, G, blk);
        if (fusedfin) {
            EpiFinal E{X1, X1, SS2, fincnt, g_final};
            pg8::gemm_phase<EpiFinal, pg8::StaticOrder, false, true>(lds, g, S, E);
        } else {
            EpiRes<false> E{X1, X1 + (size_t)TP * 1024, X1, nullptr, SS2};
            pg8::gemm_phase<EpiRes<false>, pg8::StaticOrder, true, true>(lds, g, S, E);
        }
    }
#endif
    if (G != 256) { xcd_barrier(xbar); }

#ifdef PROBE_P7
    { PHASE_IDS(); const bool dz = queue[200] == 12345u;
    for (int m = gw; m < T; m += NGW) {
        float* row = X1 + (size_t)m * 1024; const float rs = rsqrtf(SS2[m] * (1.f / 1024.f) + EPS);
#pragma unroll
        for (int j = 0; j < 4; ++j) { f32x4 v = ((f32x4*)row)[lane + 64 * j]; const f32x4 gg = ((const f32x4*)g_final)[lane + 64 * j]; if (dz) ((f32x4*)row)[lane + 64 * j] = v * rs * gg; }
    } }
#endif
#ifndef SKIP_P7
    if (G != 256) { PHASE_IDS();
    for (int m = gw; m < T; m += NGW) {
        float* row = X1 + (size_t)m * 1024; const float rs = rsqrtf(SS2[m] * (1.f / 1024.f) + EPS);
#pragma unroll
        for (int j = 0; j < 4; ++j) { f32x4 v = ((f32x4*)row)[lane + 64 * j]; const f32x4 gg = ((const f32x4*)g_final)[lane + 64 * j]; ((f32x4*)row)[lane + 64 * j] = v * rs * gg; }
    }
    }
#endif
}

extern "C" void kernel_launch(void* const* d_in, const int* in_sizes, int n_in, void* d_out, int out_size, void* d_ws, size_t ws_size, hipStream_t stream) {
    static int grid = 0;
    if (grid == 0) {
        if (n_in != 23 || out_size != (int)O_TOTAL || ws_size < 512 * HMiB) { fprintf(stderr, "kernel_launch: unexpected shapes: n_in %d out %d ws %zu\n", n_in, out_size, ws_size); grid = -1; return; }
        int dev = 0, cus = 0, per_cu = 0;
        (void)hipGetDevice(&dev); (void)hipDeviceGetAttribute(&cus, hipDeviceAttributeMultiprocessorCount, dev);
        if (hipFuncSetAttribute((const void*)fwd_megakernel, hipFuncAttributeMaxDynamicSharedMemorySize, LDS_BYTES) != hipSuccess) { fprintf(stderr, "kernel_launch: hipFuncSetAttribute failed\n"); grid = -1; return; }
        if (hipOccupancyMaxActiveBlocksPerMultiprocessor(&per_cu, (const void*)fwd_megakernel, 512, LDS_BYTES) != hipSuccess || per_cu < 1) { fprintf(stderr, "kernel_launch: occupancy query says %d\n", per_cu); per_cu = 1; }
        (void)hipGetLastError();
        grid = cus > 0 ? cus : 256;
    }
    if (grid < 0) return;
    (void)hipMemsetAsync((char*)d_ws + WS_CTL, 0, CTL_BYTES, stream);
    Args a{};
    for (int i = 0; i < 23; ++i) a.in[i] = (const float*)d_in[i];
    a.out = (float*)d_out; a.ws = (unsigned char*)d_ws;
    void* kargs[] = {&a};
    hipError_t e = hipLaunchCooperativeKernel((const void*)fwd_megakernel, dim3(grid), dim3(512), kargs, LDS_BYTES, stream);
    if (e != hipSuccess) fprintf(stderr, "kernel_launch: cooperative launch failed: %s (grid %d)\n", hipGetErrorString(e), grid);
}
```

```cpp
#include <hip/hip_runtime.h>
#include <hip/hip_cooperative_groups.h>
#include <cstdio>
#include <cstdint>
namespace cg = cooperative_groups;
namespace pg8 {
#define PG8_LAS __attribute__((address_space(3)))
typedef unsigned short bf16_t;
typedef short bf16x8 __attribute__((ext_vector_type(8)));
typedef float f32x4 __attribute__((ext_vector_type(4)));
typedef unsigned u32x4 __attribute__((ext_vector_type(4)));
constexpr int BM = 256, BK = 64, HALF = 128, HTB = HALF * BK * 2  , STAGE_BYTES = 8 * HTB, NXCD = 8, WGM = 8;

__host__ __device__ __forceinline__ int lds_byte(int r, int c) { const int st = (r >> 4) * 2 + (c >> 5), rr = r & 15, cc = c & 31, ob = rr * 64 + cc * 2; return st * 1024 + (ob ^ (((ob >> 9) & 1) << 5)); }
__host__ __device__ __forceinline__ void stage_rc(int b, int& R, int& C) { const int st = b / 1024, sb = b % 1024, swz = sb ^ (((sb >> 9) & 1) << 5); R = (st >> 1) * 16 + swz / 64; C = (st & 1) * 32 + (swz % 64) / 2; }
__host__ __device__ __forceinline__ int perm32(int rho) { const int n = rho >> 4, i = rho & 15; return 8 * (i >> 2) + 4 * n + (i & 3); }

struct Unit { int pm, pn; };
struct Gemm { const bf16_t* A; const bf16_t* Bt; int M, N, K; };

struct StaticOrder {
    int nM, nN, nwg, G, c;
    __host__ __device__ __forceinline__ void init(int M, int N, int G_, int c_) { nM = M / BM; nN = N / BM; nwg = nM * nN; G = G_; c = c_; }
    __host__ __device__ __forceinline__ bool next(int i, Unit& u) const {
        const long L = (long)i * G + c; if (L >= nwg) return false;
        int wgid = (int)L; { const int q = nwg / NXCD, r = nwg % NXCD, xcd = wgid % NXCD, off = wgid / NXCD; wgid = (xcd < r ? xcd * (q + 1) : r * (q + 1) + (xcd - r) * q) + off; }
        const int nig = WGM * nN, gid = wgid / nig, fm = gid * WGM, gsz = (nM - fm) < WGM ? (nM - fm) : WGM;
        u.pm = fm + ((wgid % nig) % gsz); u.pn = (wgid % nig) / gsz; return true;
    }
    __device__ __forceinline__ void a_ready(const Unit&) const {}
    __device__ __forceinline__ void done(const Unit&) const {}
};
__device__ __forceinline__ unsigned cvt_pk_bf16(float lo, float hi) { unsigned r; asm volatile("v_cvt_pk_bf16_f32 %0, %1, %2" : "=v"(r) : "v"(lo), "v"(hi)); return r; }
template <class Epi, class Sched, bool ALIGN_EPI = false, bool SP2 = false>
__device__ __forceinline__ void gemm_phase(PG8_LAS unsigned char* lds, const Gemm g, const Sched& S, const Epi& E) {
    int tid_ = threadIdx.x; asm volatile("" : "+v"(tid_));
    const int tid = tid_, wid = __builtin_amdgcn_readfirstlane(tid >> 6), lane = tid & 63, wr = wid >> 2, wc = wid & 3, fr = lane & 15, fq = lane >> 4;
    const int K = g.K, nt = K / BK;
    unsigned voffA[2], voffB[2];
#pragma unroll
    for (int i = 0; i < 2; ++i) { int R, C; stage_rc(tid * 16 + i * 8192, R, C); const int Rb = Epi::PERM ? ((R & ~31) + perm32(R & 31)) : R;
        voffA[i] = (unsigned)(R * K + C) * 2u; voffB[i] = (unsigned)(Rb * K + C) * 2u; }
    const size_t kstep = (size_t)(BK * 2);
    const size_t hstep = (size_t)HALF * K * 2;
    const size_t tstep = 2 * hstep;
    const unsigned ldsw = (unsigned)wid * 1024u;
    const int aoff = lds_byte(wr * 64 + fr, fq * 8), boff = lds_byte(wc * 32 + fr, fq * 8);
#define PG8_SA(b, h) (((b) * 2 + (h)) * HTB)
#define PG8_SB(b, h) ((4 + (b) * 2 + (h)) * HTB)
#define PG8_STAGE(bufoff, gbase, voff) do { _Pragma("unroll") for (int _i = 0; _i < 2; ++_i) \
        __builtin_amdgcn_global_load_lds((const unsigned*)((const char*)(gbase) + (voff)[_i]), (PG8_LAS unsigned*)(lds + (bufoff) + ldsw + _i * 8192), 16, 0, 0); } while (0)
#define PG8_LDA(dst, b, h) do { _Pragma("unroll") for (int m = 0; m < 4; ++m) _Pragma("unroll") for (int k = 0; k < 2; ++k) dst[m][k] = *(const PG8_LAS bf16x8*)(lds + PG8_SA(b, h) + aoff + m * 2048 + k * 1024); } while (0)
#define PG8_LDB(dst, b, h) do { _Pragma("unroll") for (int n = 0; n < 2; ++n) _Pragma("unroll") for (int k = 0; k < 2; ++k) dst[n][k] = *(const PG8_LAS bf16x8*)(lds + PG8_SB(b, h) + boff + n * 2048 + k * 1024); } while (0)
#define PG8_MMA(ai, bj, At, Bt) do { __builtin_amdgcn_s_setprio(1); _Pragma("unroll") for (int m = 0; m < 4; ++m) _Pragma("unroll") for (int n = 0; n < 2; ++n) _Pragma("unroll") for (int k = 0; k < 2; ++k) \
        acc[ai][bj][m][n] = __builtin_amdgcn_mfma_f32_16x16x32_bf16(Bt[n][k], At[m][k], acc[ai][bj][m][n], 0, 0, 0); __builtin_amdgcn_s_setprio(0); } while (0)
#define PG8_WAIT_V(n) asm volatile("s_waitcnt vmcnt(" #n ")" ::: "memory")
#define PG8_WAIT_L(n) asm volatile("s_waitcnt lgkmcnt(" #n ")" ::: "memory")
#define PG8_BAR __builtin_amdgcn_s_barrier()
#define PG8_SCHED __builtin_amdgcn_sched_barrier(0)
    Unit cur, nxt; int ui = 0;
    if (!S.next(0, cur)) return;
    f32x4 acc[2][2][4][2];
#pragma unroll
    for (int a = 0; a < 2; ++a)
#pragma unroll
        for (int b = 0; b < 2; ++b)
#pragma unroll
            for (int m = 0; m < 4; ++m)
#pragma unroll
                for (int n = 0; n < 2; ++n) acc[a][b][m][n] = (f32x4){0.f, 0.f, 0.f, 0.f};
    bf16x8 At[4][2], B0[2][2], B1[2][2];
    const char* cA = (const char*)g.A + (size_t)cur.pm * tstep; const char* cB = (const char*)g.Bt + (size_t)cur.pn * tstep;
    S.a_ready(cur);
    if constexpr (SP2) {
        PG8_STAGE(PG8_SB(0, 0), cB, voffB); PG8_STAGE(PG8_SB(0, 1), cB + hstep, voffB); PG8_STAGE(PG8_SA(0, 0), cA, voffA); PG8_STAGE(PG8_SA(0, 1), cA + hstep, voffA);
        if (wr == 1) PG8_BAR;
        PG8_WAIT_V(2); PG8_BAR;
        PG8_STAGE(PG8_SB(1, 0), cB + kstep, voffB); PG8_STAGE(PG8_SA(1, 0), cA + kstep, voffA); PG8_STAGE(PG8_SB(1, 1), cB + hstep + kstep, voffB);
        PG8_WAIT_V(6); PG8_BAR;
    } else {
        PG8_STAGE(PG8_SB(0, 0), cB, voffB); PG8_STAGE(PG8_SA(0, 0), cA, voffA); PG8_STAGE(PG8_SB(0, 1), cB + hstep, voffB); PG8_STAGE(PG8_SA(0, 1), cA + hstep, voffA);
        if (wr == 1) PG8_BAR;
        PG8_WAIT_V(4); PG8_BAR;
        PG8_STAGE(PG8_SB(1, 0), cB + kstep, voffB); PG8_STAGE(PG8_SA(1, 0), cA + kstep, voffA); PG8_STAGE(PG8_SB(1, 1), cB + hstep + kstep, voffB);
        PG8_WAIT_V(6); PG8_BAR;
    }
    for (;;) {
        const bool has_next = S.next(ui + 1, nxt);
        const char* nA = has_next ? (const char*)g.A + (size_t)nxt.pm * tstep : cA; const char* nB = has_next ? (const char*)g.Bt + (size_t)nxt.pn * tstep : cB;
        for (int t = 0; t < nt; t += 2) {
            const bool last = (t == nt - 2);
            const char* a1 = cA + (size_t)(t + 1) * kstep;
            const char* a2 = last ? nA : cA + (size_t)(t + 2) * kstep; const char* b2 = last ? nB : cB + (size_t)(t + 2) * kstep;
            const char* a3 = a2 + kstep; const char* b3 = b2 + kstep;
            if (last && has_next) S.a_ready(nxt);
            if constexpr (SP2) {
            PG8_LDB(B0, 0, 0); PG8_LDB(B1, 0, 1); PG8_SCHED; PG8_LDA(At, 0, 0); PG8_STAGE(PG8_SA(1, 1), a1 + hstep, voffA);
            PG8_WAIT_V(8); PG8_WAIT_L(0); PG8_BAR; PG8_MMA(0, 0, At, B0); PG8_MMA(0, 1, At, B1); PG8_BAR; PG8_SCHED;
            PG8_LDA(At, 0, 1); PG8_STAGE(PG8_SB(0, 0), b2, voffB); PG8_STAGE(PG8_SB(0, 1), b2 + hstep, voffB); PG8_STAGE(PG8_SA(0, 0), a2, voffA);
            PG8_WAIT_V(8); PG8_WAIT_L(0); PG8_BAR; PG8_MMA(1, 0, At, B0); PG8_MMA(1, 1, At, B1); PG8_BAR; PG8_SCHED;
            PG8_LDB(B0, 1, 0); PG8_LDB(B1, 1, 1); PG8_SCHED; PG8_LDA(At, 1, 0); PG8_STAGE(PG8_SA(0, 1), a2 + hstep, voffA);
            PG8_WAIT_V(8); PG8_WAIT_L(0); PG8_BAR; PG8_MMA(0, 0, At, B0); PG8_MMA(0, 1, At, B1); PG8_BAR; PG8_SCHED;
            PG8_LDA(At, 1, 1); PG8_STAGE(PG8_SB(1, 0), b3, voffB); PG8_STAGE(PG8_SB(1, 1), b3 + hstep, voffB); PG8_STAGE(PG8_SA(1, 0), a3, voffA);
            PG8_WAIT_V(8); PG8_WAIT_L(0); PG8_BAR; PG8_MMA(1, 0, At, B0); PG8_MMA(1, 1, At, B1); PG8_BAR; PG8_SCHED;
            } else {
            PG8_LDB(B0, 0, 0); PG8_SCHED; PG8_LDA(At, 0, 0); PG8_STAGE(PG8_SA(1, 1), a1 + hstep, voffA);
            PG8_WAIT_L(8); PG8_BAR; PG8_WAIT_L(0); PG8_MMA(0, 0, At, B0); PG8_BAR; PG8_SCHED;
            PG8_LDB(B1, 0, 1); PG8_STAGE(PG8_SB(0, 0), b2, voffB);
            PG8_BAR; PG8_WAIT_L(0); PG8_MMA(0, 1, At, B1); PG8_BAR;
            PG8_LDA(At, 0, 1); PG8_STAGE(PG8_SA(0, 0), a2, voffA);
            PG8_BAR; PG8_WAIT_L(0); PG8_MMA(1, 0, At, B0); PG8_BAR; PG8_SCHED;
            PG8_STAGE(PG8_SB(0, 1), b2 + hstep, voffB);
            PG8_WAIT_V(6); PG8_BAR; PG8_MMA(1, 1, At, B1); PG8_BAR;
            PG8_LDB(B0, 1, 0); PG8_SCHED; PG8_LDA(At, 1, 0); PG8_STAGE(PG8_SA(0, 1), a2 + hstep, voffA);
            PG8_WAIT_L(8); PG8_BAR; PG8_WAIT_L(0); PG8_MMA(0, 0, At, B0); PG8_BAR; PG8_SCHED;
            PG8_LDB(B1, 1, 1); PG8_STAGE(PG8_SB(1, 0), b3, voffB);
            PG8_BAR; PG8_WAIT_L(0); PG8_MMA(0, 1, At, B1); PG8_BAR;
            PG8_LDA(At, 1, 1); PG8_STAGE(PG8_SA(1, 0), a3, voffA);
            PG8_BAR; PG8_WAIT_L(0); PG8_MMA(1, 0, At, B0); PG8_BAR; PG8_SCHED;
            PG8_STAGE(PG8_SB(1, 1), b3 + hstep, voffB);
            PG8_WAIT_V(6); PG8_BAR; PG8_MMA(1, 1, At, B1); PG8_BAR;
            }
        }
        if constexpr (ALIGN_EPI) { if (wr == 0) PG8_BAR; }
        if constexpr (!Epi::AFTER_DRAIN) { E(acc, cur, wr, wc, fr, fq); S.done(cur); }
        if (!has_next) break;
#pragma unroll
        for (int a = 0; a < 2; ++a)
#pragma unroll
            for (int b = 0; b < 2; ++b)
#pragma unroll
                for (int m = 0; m < 4; ++m)
#pragma unroll
                    for (int n = 0; n < 2; ++n) acc[a][b][m][n] = (f32x4){0.f, 0.f, 0.f, 0.f};
        cur = nxt; cA = nA; cB = nB; ++ui;
        if constexpr (ALIGN_EPI) { if (wr == 1) PG8_BAR; }
    }
    PG8_WAIT_V(0);
    if constexpr (!ALIGN_EPI) { if (wr == 0) PG8_BAR; }
    PG8_BAR;
    if constexpr (Epi::AFTER_DRAIN) { E.fused(acc, cur, wr, wc, fr, fq, lds, wid, lane); S.done(cur); }
#undef PG8_SA
#undef PG8_SB
#undef PG8_STAGE
#undef PG8_LDA
#undef PG8_LDB
#undef PG8_MMA
#undef PG8_WAIT_V
#undef PG8_WAIT_L
#undef PG8_BAR
#undef PG8_SCHED
}
}

using pg8::bf16_t; using pg8::f32x4; using pg8::bf16x8; using pg8::u32x4; using pg8::Unit;
#define LAS __attribute__((address_space(3)))
typedef unsigned u32x2 __attribute__((ext_vector_type(2)));
typedef short s16x4 __attribute__((ext_vector_type(4)));
typedef float f32x2_t __attribute__((ext_vector_type(2)));
typedef __bf16 bf16x2_t __attribute__((ext_vector_type(2)));

constexpr int TP = 16384, TSMP = 256, T = TP + TSMP, DM = 1024, DFF = 2816;
constexpr float EPS = 1e-6f;
constexpr size_t HMiB = 524288;
constexpr size_t WS_CTL = 0, CTL_BYTES = 2 * HMiB;
constexpr size_t WS_MKB = 2 * HMiB, WS_MVT = 12 * HMiB;
constexpr size_t WS_FFNIN = 2 * HMiB, WS_FFNDN = 24 * HMiB, WS_WOUT = 35 * HMiB, WS_BRRET = 39 * HMiB, WS_BRCONV = 47 * HMiB, WS_BRMEM = 51 * HMiB, WS_WIN = 55 * HMiB, WS_WMEMKV = 107 * HMiB;
constexpr size_t WS_HN = 115 * HMiB, WS_V = 180 * HMiB, WS_CB = 310 * HMiB, WS_P = 375 * HMiB, WS_MQ = 440 * HMiB, WS_END1 = 505 * HMiB;
constexpr size_t WS_MERGED = WS_P;
constexpr size_t WS_X1B = 39 * HMiB, WS_ABUF = 104 * HMiB, WS_UBUF = WS_ABUF + (size_t)T * DFF * 2, WS_END2 = WS_UBUF + (size_t)T * DFF * 2;
static_assert(WS_END2 <= 512 * HMiB && WS_END1 <= 512 * HMiB, "ws map");
constexpr size_t CTL_QUEUE = 0, CTL_SS1 = 4096, CTL_SS2 = 73728, CTL_STAT = 143360, CTL_FIN = 704512, CTL_XBAR = 720896;
static_assert(CTL_STAT + (size_t)T * 8 * 4 <= CTL_BYTES, "ctl");
constexpr size_t O_Y = 0, O_RETP = 17039360, O_CONVP = 18087936, O_FFNP = 18092032, O_MKP = 18103296, O_MVP = 18627584, O_RETS = 19151872, O_CONVS = 23346176, O_FFNS = 23362560, O_TOTAL = 23407616;
constexpr int LDS_BYTES = 147456, LDS_CTLOFF = LDS_BYTES - 128;

#ifndef REP_P0
#define REP_P0 1
#endif
#ifndef REP_P1
#define REP_P1 1
#endif
#ifndef REP_P3
#define REP_P3 1
#endif
#ifndef REP_P5
#define REP_P5 1
#endif
struct Args { const float* in[23]; float* out; unsigned char* ws; };

__device__ __forceinline__ unsigned pk2(float lo, float hi) { f32x2_t v = {lo, hi}; bf16x2_t b = __builtin_convertvector(v, bf16x2_t); return __builtin_bit_cast(unsigned, b); }
__device__ __forceinline__ float bflo(unsigned w) { return __builtin_bit_cast(float, w << 16); }
__device__ __forceinline__ float bfhi(unsigned w) { return __builtin_bit_cast(float, w & 0xffff0000u); }
__device__ __forceinline__ float sigm_f(float x) { return __builtin_amdgcn_rcpf(1.f + __expf(-x)); }
__device__ __forceinline__ float silu_f(float x) { return x * sigm_f(x); }
__device__ __forceinline__ f32x4 mfma16(bf16x8 a, bf16x8 b, f32x4 c) { return __builtin_amdgcn_mfma_f32_16x16x32_bf16(a, b, c, 0, 0, 0); }
__device__ __forceinline__ float wave_sum(float v) {
#pragma unroll
    for (int o = 1; o < 64; o <<= 1) v += __shfl_xor(v, o);
    return v;
}
__device__ __forceinline__ int tok_pos(int r) { return r < TP ? (r & 8191) : 1024 + ((r - TP) & 31); }
__device__ __forceinline__ bool tok_batch_start(int r) { return r < TP ? ((r & 8191) == 0) : (((r - TP) & 31) == 0); }

#define EPI_ARGS const f32x4 (&acc)[2][2][4][2], const Unit& u, int wr, int wc, int fr, int fq
__device__ __forceinline__ u32x4 pack8(const f32x4& a, const f32x4& b) { u32x4 w; w.x = pk2(a[0], a[1]); w.y = pk2(a[2], a[3]); w.z = pk2(b[0], b[1]); w.w = pk2(b[2], b[3]); return w; }

struct EpiZ1a {
    static constexpr bool PERM = true, AFTER_DRAIN = false;
    bf16_t *QK, *V, *CB, *P, *MQ;
    __device__ __forceinline__ void operator()(EPI_ARGS) const {
        const int row0 = u.pm * 256 + wr * 64 + fr, cl = wc * 32 + 8 * fq, pn = u.pn;
        if (pn < 8) {
            const float sc = pn >= 4 ? 0.0625f : 1.0f;
            float inv[8];
#pragma unroll
            for (int j = 0; j < 8; ++j) inv[j] = exp2f(-(float)(cl + j) * 0.10381025296523f) * 0.15915494309189535f;
#pragma unroll
            for (int ai = 0; ai < 2; ++ai)
#pragma unroll
                for (int m = 0; m < 4; ++m) {
                    const int r = row0 + ai * 128 + m * 16; const float pos = (float)tok_pos(r);
                    f32x4 o1[2], o2[2];
#pragma unroll
                    for (int n = 0; n < 2; ++n)
#pragma unroll
                        for (int i = 0; i < 4; ++i) {
                            float rev = pos * inv[4 * n + i]; rev -= floorf(rev);
                            const float s = __builtin_amdgcn_sinf(rev), c = __builtin_amdgcn_cosf(rev);
                            const float x1 = acc[ai][0][m][n][i], x2 = acc[ai][1][m][n][i];
                            o1[n][i] = (x1 * c - x2 * s) * sc; o2[n][i] = (x1 * s + x2 * c) * sc;
                        }
                    bf16_t* dst = QK + (size_t)pn * ((size_t)T * 256) + (size_t)r * 256 + cl;
                    *(u32x4*)dst = pack8(o1[0], o1[1]); *(u32x4*)(dst + 128) = pack8(o2[0], o2[1]);
                }
        } else if (pn < 20) {
            bf16_t* base; int ldc, c0;
            if (pn < 16) { base = V; ldc = 2048; c0 = (pn - 8) * 256; } else { base = CB; ldc = 1024; c0 = (pn - 16) * 256; }
#pragma unroll
            for (int ai = 0; ai < 2; ++ai)
#pragma unroll
                for (int m = 0; m < 4; ++m) {
                    bf16_t* dst = base + (size_t)(row0 + ai * 128 + m * 16) * ldc + c0 + cl;
#pragma unroll
                    for (int bj = 0; bj < 2; ++bj) *(u32x4*)(dst + bj * 128) = pack8(acc[ai][bj][m][0], acc[ai][bj][m][1]);
                }
        } else if (pn < 28) {
#pragma unroll
            for (int ai = 0; ai < 2; ++ai)
#pragma unroll
                for (int m = 0; m < 4; ++m) {
                    bf16_t* dst = P + (size_t)(row0 + ai * 128 + m * 16) * 1024 + (pn - 20) * 128 + cl;
                    *(u32x4*)dst = pack8(acc[ai][0][m][0] * acc[ai][1][m][0], acc[ai][0][m][1] * acc[ai][1][m][1]);
                }
        } else {
            const float sc = 0.0625f * 1.4426950408889634f;
#pragma unroll
            for (int ai = 0; ai < 2; ++ai)
#pragma unroll
                for (int m = 0; m < 4; ++m) {
                    bf16_t* dst = MQ + (size_t)(row0 + ai * 128 + m * 16) * 1024 + (pn - 28) * 256 + cl;
#pragma unroll
                    for (int bj = 0; bj < 2; ++bj) *(u32x4*)(dst + bj * 128) = pack8(acc[ai][bj][m][0] * sc, acc[ai][bj][m][1] * sc);
                }
        }
    }
};

struct EpiMemKV {
    static constexpr bool PERM = false, AFTER_DRAIN = false;
    float *outK, *outV; bf16_t *MKb, *MVt;
    __device__ __forceinline__ void operator()(EPI_ARGS) const {
        const int row0 = u.pm * 256 + wr * 64 + fr;
#pragma unroll
        for (int ai = 0; ai < 2; ++ai)
#pragma unroll
            for (int m = 0; m < 4; ++m) {
                const int r = row0 + ai * 128 + m * 16;
#pragma unroll
                for (int bj = 0; bj < 2; ++bj)
#pragma unroll
                    for (int n = 0; n < 2; ++n) {
                        const int c = u.pn * 256 + bj * 128 + wc * 32 + n * 16 + 4 * fq; const f32x4 v = acc[ai][bj][m][n];
                        if (u.pn < 4) { *(f32x4*)(outK + (size_t)r * 1024 + c) = v; u32x2 w; w.x = pk2(v[0], v[1]); w.y = pk2(v[2], v[3]); *(u32x2*)(MKb + (size_t)r * 1024 + c) = w; }
                        else {
                            const int cv = c - 1024; *(f32x4*)(outV + (size_t)r * 1024 + cv) = v;
                            const int b = r >> 8, mm = r & 255, pos = (mm & ~31) + 8 * ((mm >> 2) & 3) + 4 * ((mm >> 4) & 1) + (mm & 3);
#pragma unroll
                            for (int i = 0; i < 4; ++i) MVt[((size_t)b * 1024 + cv + i) * 256 + pos] = (bf16_t)(pk2(v[i], 0.f) & 0xffffu);
                        }
                    }
            }
    }
};

struct EpiGR {
    static constexpr bool PERM = true, AFTER_DRAIN = false;
    const bf16_t* O; bf16_t* ON; const float* stat; const float* ggn;
    __device__ __forceinline__ void operator()(EPI_ARGS) const {
        const int row0 = u.pm * 256 + wr * 64 + fr, cl = wc * 32 + 8 * fq, h = u.pn >> 1;
        f32x4 gv[2][2];
#pragma unroll
        for (int bj = 0; bj < 2; ++bj)
#pragma unroll
            for (int n = 0; n < 2; ++n) gv[bj][n] = *(const f32x4*)(ggn + u.pn * 256 + bj * 128 + cl + 4 * n);
#pragma unroll
        for (int ai = 0; ai < 2; ++ai) {
            u32x4 oq[4][2]; f32x2_t sq[4];
#pragma unroll
            for (int m = 0; m < 4; ++m) {
                const int r = row0 + ai * 128 + m * 16; sq[m] = *(const f32x2_t*)(stat + (size_t)r * 8 + 2 * h);
#pragma unroll
                for (int bj = 0; bj < 2; ++bj) oq[m][bj] = *(const u32x4*)(O + (size_t)r * 2048 + u.pn * 256 + bj * 128 + cl);
            }
            __builtin_amdgcn_sched_barrier(0);
#pragma unroll
            for (int m = 0; m < 4; ++m) {
                const int r = row0 + ai * 128 + m * 16;
                const float mu = sq[m].x * (1.f / 512.f), var = fmaxf(sq[m].y * (1.f / 512.f) - mu * mu, 0.f), rstd = rsqrtf(var + EPS);
#pragma unroll
                for (int bj = 0; bj < 2; ++bj) {
                    const size_t po = (size_t)r * 2048 + u.pn * 256 + bj * 128 + cl;
                    const u32x4 ov = oq[m][bj]; f32x4 o0, o1;
                    o0[0] = bflo(ov.x); o0[1] = bfhi(ov.x); o0[2] = bflo(ov.y); o0[3] = bfhi(ov.y); o1[0] = bflo(ov.z); o1[1] = bfhi(ov.z); o1[2] = bflo(ov.w); o1[3] = bfhi(ov.w);
                    f32x4 a0 = acc[ai][bj][m][0], a1 = acc[ai][bj][m][1];
#pragma unroll
                    for (int i = 0; i < 4; ++i) { a0[i] = (o0[i] - mu) * rstd * gv[bj][0][i] * silu_f(a0[i]); a1[i] = (o1[i] - mu) * rstd * gv[bj][1][i] * silu_f(a1[i]); }
                    *(u32x4*)(ON + po) = pack8(a0, a1);
                }
            }
        }
    }
};

struct EpiNull {
    static constexpr bool PERM = true, AFTER_DRAIN = false;
    const unsigned* flag; float* sink;
    __device__ __forceinline__ void operator()(EPI_ARGS) const {
        if (*flag == 12345u) {
#pragma unroll
            for (int ai = 0; ai < 2; ++ai)
#pragma unroll
                for (int m = 0; m < 4; ++m)
#pragma unroll
                    for (int bj = 0; bj < 2; ++bj) { sink[(u.pm * 256 + wr * 64 + fr + ai * 128 + m * 16) * 16 + wc + fq + bj] = acc[ai][bj][m][0][0] + acc[ai][bj][m][1][1]; }
        }
    }
};
struct EpiGate {
    static constexpr bool PERM = true, AFTER_DRAIN = false;
    bf16_t* S;
    __device__ __forceinline__ void operator()(EPI_ARGS) const {
        const int row0 = u.pm * 256 + wr * 64 + fr, cl = wc * 32 + 8 * fq;
#pragma unroll
        for (int ai = 0; ai < 2; ++ai)
#pragma unroll
            for (int m = 0; m < 4; ++m)
#pragma unroll
                for (int bj = 0; bj < 2; ++bj) {
                    f32x4 a0 = acc[ai][bj][m][0], a1 = acc[ai][bj][m][1];
#pragma unroll
                    for (int i = 0; i < 4; ++i) { a0[i] = sigm_f(a0[i]); a1[i] = sigm_f(a1[i]); }
                    *(u32x4*)(S + (size_t)(row0 + ai * 128 + m * 16) * 1024 + u.pn * 256 + bj * 128 + cl) = pack8(a0, a1);
                }
    }
};
template <bool FIRST> struct EpiBranch {
    static constexpr bool PERM = true, AFTER_DRAIN = false;
    const bf16_t* S; bf16_t* Mg;
    __device__ __forceinline__ void operator()(EPI_ARGS) const {
        const int row0 = u.pm * 256 + wr * 64 + fr, cl = wc * 32 + 8 * fq;
#pragma unroll
        for (int ai = 0; ai < 2; ++ai) {
            u32x4 gq[4][2], oq[4][2];
#pragma unroll
            for (int m = 0; m < 4; ++m)
#pragma unroll
                for (int bj = 0; bj < 2; ++bj) {
                    const size_t off = (size_t)(row0 + ai * 128 + m * 16) * 1024 + u.pn * 256 + bj * 128 + cl;
                    gq[m][bj] = *(const u32x4*)(S + off); if (!FIRST) oq[m][bj] = *(const u32x4*)(Mg + off);
                }
            __builtin_amdgcn_sched_barrier(0);
#pragma unroll
            for (int m = 0; m < 4; ++m)
#pragma unroll
                for (int bj = 0; bj < 2; ++bj) {
                    const size_t off = (size_t)(row0 + ai * 128 + m * 16) * 1024 + u.pn * 256 + bj * 128 + cl;
                    const u32x4 g = gq[m][bj];
                    f32x4 a0 = acc[ai][bj][m][0], a1 = acc[ai][bj][m][1];
                    a0[0] *= bflo(g.x); a0[1] *= bfhi(g.x); a0[2] *= bflo(g.y); a0[3] *= bfhi(g.y); a1[0] *= bflo(g.z); a1[1] *= bfhi(g.z); a1[2] *= bflo(g.w); a1[3] *= bfhi(g.w);
                    if (!FIRST) { const u32x4 o = oq[m][bj];
                        a0[0] += bflo(o.x); a0[1] += bfhi(o.x); a0[2] += bflo(o.y); a0[3] += bfhi(o.y); a1[0] += bflo(o.z); a1[1] += bfhi(o.z); a1[2] += bflo(o.w); a1[3] += bfhi(o.w); }
                    *(u32x4*)(Mg + off) = pack8(a0, a1);
                }
        }
    }
};

template <bool WITHB> struct EpiRes {
    static constexpr bool PERM = false, AFTER_DRAIN = false;
    const float* xp; const float* xs; float* xo; bf16_t* xb; float* ss;
    __device__ __forceinline__ void operator()(EPI_ARGS) const {
        const int row0 = u.pm * 256 + wr * 64 + fr;
#pragma unroll
        for (int ai = 0; ai < 2; ++ai) {
            f32x4 xv[4][2][2];
#pragma unroll
            for (int m = 0; m < 4; ++m) {
                const int r = row0 + ai * 128 + m * 16;
                const float* xin = r < TP ? xp + (size_t)r * 1024 : xs + (size_t)(r - TP) * 1024;
#pragma unroll
                for (int bj = 0; bj < 2; ++bj)
#pragma unroll
                    for (int n = 0; n < 2; ++n) xv[m][bj][n] = *(const f32x4*)(xin + u.pn * 256 + bj * 128 + wc * 32 + n * 16 + 4 * fq);
            }
            __builtin_amdgcn_sched_barrier(0);
#pragma unroll
            for (int m = 0; m < 4; ++m) {
                const int r = row0 + ai * 128 + m * 16;
                float q = 0.f;
#pragma unroll
                for (int bj = 0; bj < 2; ++bj)
#pragma unroll
                    for (int n = 0; n < 2; ++n) {
                        const int c = u.pn * 256 + bj * 128 + wc * 32 + n * 16 + 4 * fq;
                        const f32x4 v = xv[m][bj][n] + acc[ai][bj][m][n];
                        *(f32x4*)(xo + (size_t)r * 1024 + c) = v;
                        if (WITHB) { u32x2 w; w.x = pk2(v[0], v[1]); w.y = pk2(v[2], v[3]); *(u32x2*)(xb + (size_t)r * 1024 + c) = w; }
                        q += (v[0] * v[0] + v[1] * v[1]) + (v[2] * v[2] + v[3] * v[3]);
                    }
                q += __shfl_xor(q, 16); q += __shfl_xor(q, 32);
                if (fq == 0) atomicAdd(ss + r, q);
            }
        }
    }
};

__device__ __forceinline__ unsigned ld_agent(const unsigned* p) { return __hip_atomic_load(p, __ATOMIC_RELAXED, __HIP_MEMORY_SCOPE_AGENT); }
__device__ __forceinline__ float ld_agent_f(const float* p) { return __uint_as_float(__hip_atomic_load((const unsigned*)p, __ATOMIC_RELAXED, __HIP_MEMORY_SCOPE_AGENT)); }
__device__ __forceinline__ void panel_arrive_and_wait(unsigned* cnt, unsigned want) {
    asm volatile("s_waitcnt vmcnt(0)" ::: "memory");
    __syncthreads();
    if (threadIdx.x == 0) {
        __builtin_amdgcn_fence(__ATOMIC_RELEASE, "agent");
        asm volatile("s_waitcnt vmcnt(0)" ::: "memory");
        __hip_atomic_fetch_add(cnt, 1u, __ATOMIC_RELAXED, __HIP_MEMORY_SCOPE_AGENT);
        unsigned sp = 0;
        while (ld_agent(cnt) < want) { __builtin_amdgcn_s_sleep(2); if (++sp > (1u << 22)) break; }
        __builtin_amdgcn_fence(__ATOMIC_ACQUIRE, "agent");
    }
    __syncthreads();
}
struct EpiFinal {
    static constexpr bool PERM = false, AFTER_DRAIN = true;
    const float* x1; float* y; float* ss; unsigned* cnt; const float* gfin;
    __device__ __forceinline__ void operator()(EPI_ARGS) const {}
    __device__ __forceinline__ void fused(f32x4 (&acc)[2][2][4][2], const Unit& u, int wr, int wc, int fr, int fq, PG8_LAS unsigned char* lds, int wid, int lane) const {
        const int row0 = u.pm * 256 + wr * 64 + fr;
#pragma unroll
        for (int ai = 0; ai < 2; ++ai)
#pragma unroll
            for (int m = 0; m < 4; ++m) {
                const int r = row0 + ai * 128 + m * 16; float q = 0.f;
#pragma unroll
                for (int bj = 0; bj < 2; ++bj)
#pragma unroll
                    for (int n = 0; n < 2; ++n) {
                        const int c = u.pn * 256 + bj * 128 + wc * 32 + n * 16 + 4 * fq;
                        const f32x4 v = *(const f32x4*)(x1 + (size_t)r * 1024 + c) + acc[ai][bj][m][n];
                        acc[ai][bj][m][n] = v; q += (v[0] * v[0] + v[1] * v[1]) + (v[2] * v[2] + v[3] * v[3]);
                    }
                q += __shfl_xor(q, 16); q += __shfl_xor(q, 32);
                if (fq == 0) atomicAdd(ss + r, q);
            }
        panel_arrive_and_wait(cnt + 16 * u.pm, 4u);
#pragma unroll
        for (int ai = 0; ai < 2; ++ai)
#pragma unroll
            for (int m = 0; m < 4; ++m) {
                const int r = row0 + ai * 128 + m * 16; const float rs = rsqrtf(ld_agent_f(ss + r) * (1.f / 1024.f) + EPS);
#pragma unroll
                for (int bj = 0; bj < 2; ++bj)
#pragma unroll
                    for (int n = 0; n < 2; ++n) {
                        const int c = u.pn * 256 + bj * 128 + wc * 32 + n * 16 + 4 * fq;
                        *(f32x4*)(y + (size_t)r * 1024 + c) = acc[ai][bj][m][n] * rs * *(const f32x4*)(gfin + c);
                    }
            }
    }
};

struct EpiUp {
    static constexpr bool PERM = true, AFTER_DRAIN = false;
    bf16_t *A, *U; const float* ss; float *outP, *outS;
    __device__ __forceinline__ void operator()(EPI_ARGS) const {
        const int row0 = u.pm * 256 + wr * 64 + fr, ch = u.pn * 128 + wc * 32 + 8 * fq;
        float ssv[2][4];
#pragma unroll
        for (int ai = 0; ai < 2; ++ai)
#pragma unroll
            for (int m = 0; m < 4; ++m) ssv[ai][m] = ss[row0 + ai * 128 + m * 16];
        __builtin_amdgcn_sched_barrier(0);
#pragma unroll
        for (int ai = 0; ai < 2; ++ai)
#pragma unroll
            for (int m = 0; m < 4; ++m) {
                const int r = row0 + ai * 128 + m * 16; const float rs = rsqrtf(ssv[ai][m] * (1.f / 1024.f) + EPS);
                const f32x4 a0 = acc[ai][0][m][0] * rs, a1 = acc[ai][0][m][1] * rs;
                *(u32x4*)(A + (size_t)r * DFF + ch) = pack8(a0, a1);
                *(u32x4*)(U + (size_t)r * DFF + ch) = pack8(acc[ai][1][m][0] * rs, acc[ai][1][m][1] * rs);
                float* so = nullptr;
                if (r < TP) { const int t = r & 8191; if (t >= 8190) so = outP + ((size_t)(r >> 13) * 2 + (t - 8190)) * DFF; }
                else { const int t = (r - TP) & 31; if (t >= 30) so = outS + ((size_t)((r - TP) >> 5) * 2 + (t - 30)) * DFF; }
                if (so) { *(f32x4*)(so + ch) = a0; *(f32x4*)(so + ch + 4) = a1; }
            }
    }
};

template <bool PERMK>
__device__ __forceinline__ void transpose_item(const float* W, int N, bf16_t* WT, int ldt, int k0, int n0, int drow0, const float* kscale, LAS float* scr, int lane) {
    float tv[32];
#pragma unroll
    for (int i = 0; i < 32; ++i) tv[i] = W[(size_t)(k0 + 2 * i + (lane >> 5)) * N + n0 + (lane & 31)];
#pragma unroll
    for (int i = 0; i < 32; ++i) { const int kk = 2 * i + (lane >> 5); float v = tv[i]; if (kscale) v *= kscale[k0 + kk]; scr[kk * 33 + (lane & 31)] = v; }
    asm volatile("s_waitcnt lgkmcnt(0)" ::: "memory");
    const int c = lane & 7;
#pragma unroll
    for (int j = 0; j < 4; ++j) {
        const int n = (lane >> 3) + 8 * j; float e[8];
#pragma unroll
        for (int q = 0; q < 8; ++q) { const int kk = PERMK ? ((c >> 2) * 32 + 16 * (q >> 2) + 4 * (c & 3) + (q & 3)) : (8 * c + q); e[q] = scr[kk * 33 + n]; }
        u32x4 o; o.x = pk2(e[0], e[1]); o.y = pk2(e[2], e[3]); o.z = pk2(e[4], e[5]); o.w = pk2(e[6], e[7]);
        *(u32x4*)(WT + (size_t)(drow0 + n) * ldt + k0 + 8 * c) = o;
    }
    asm volatile("s_waitcnt lgkmcnt(0)" ::: "memory");
}
__device__ __forceinline__ int map_win(int n) {
    if (n < 4096) return n;
    if (n < 6144) return 8192 + (n - 4096);
    if (n < 7168) return 4096 + (n - 6144);
    if (n < 8192) { const int ch = n - 7168; return 5120 + (ch >> 7) * 256 + (ch & 127); }
    if (n < 9216) { const int ch = n - 8192; return 5120 + (ch >> 7) * 256 + 128 + (ch & 127); }
    if (n < 10240) return 7168 + (n - 9216);
    return n;
}
__device__ __forceinline__ int map_ffn(int c) { if (c < DFF) return (c >> 7) * 256 + (c & 127); c -= DFF; return (c >> 7) * 256 + 128 + (c & 127); }
__device__ __forceinline__ void row_norm_bf16(const float* xrow, const float* g, bf16_t* orow, int lane, bool norm) {
    f32x4 v[4]; float s = 0.f;
#pragma unroll
    for (int j = 0; j < 4; ++j) { v[j] = ((const f32x4*)xrow)[lane + 64 * j]; s += (v[j][0] * v[j][0] + v[j][1] * v[j][1]) + (v[j][2] * v[j][2] + v[j][3] * v[j][3]); }
    float rs = 1.f;
    if (norm) rs = rsqrtf(wave_sum(s) * (1.f / 1024.f) + EPS);
#pragma unroll
    for (int j = 0; j < 4; ++j) { f32x4 gg = norm ? ((const f32x4*)g)[lane + 64 * j] : (f32x4){1.f, 1.f, 1.f, 1.f}; u32x2 w; w.x = pk2(v[j][0] * rs * gg[0], v[j][1] * rs * gg[1]); w.y = pk2(v[j][2] * rs * gg[2], v[j][3] * rs * gg[3]); ((u32x2*)orow)[lane + 64 * j] = w; }
}

constexpr int SC_QS = 264, SC_KS = 272, SC_VS = 40, SC_SS = 40, SC_NCW = 2;
constexpr int SC_Q = 0, SC_K = 32 * SC_QS * 2, SC_V = SC_K + 32 * SC_KS * 2, SC_BUF = SC_V + 32 * SC_VS * 2, SC_S = 2 * SC_BUF, SC_SSZ = 32 * SC_SS * 2, SC_TOTAL = SC_S + 2 * SC_SSZ;
static_assert(SC_TOTAL <= 131072, "scan lds");
__device__ __forceinline__ s16x4 tr16(const LAS bf16_t* p) { typedef short v4i16 __attribute__((ext_vector_type(4))); return __builtin_bit_cast(s16x4, __builtin_amdgcn_ds_read_tr16_b64_v4i16((LAS v4i16*)p)); }
__device__ __forceinline__ bf16x8 cat8(s16x4 a, s16x4 b) { return (bf16x8){a[0], a[1], a[2], a[3], b[0], b[1], b[2], b[3]}; }

__device__ __forceinline__ void scan_scores(const LAS bf16_t* Qs, const LAS bf16_t* Ks, LAS bf16_t* Ss, int lane) {
    typedef float f32x16 __attribute__((ext_vector_type(16)));
    const int r32 = lane & 31, hh = lane >> 5;
    const LAS bf16_t* kp = Ks + r32 * SC_KS + 8 * hh; const LAS bf16_t* qp = Qs + r32 * SC_QS + 8 * hh;
    f32x16 sc = {0.f, 0.f, 0.f, 0.f, 0.f, 0.f, 0.f, 0.f, 0.f, 0.f, 0.f, 0.f, 0.f, 0.f, 0.f, 0.f};
#pragma unroll
    for (int half = 0; half < 2; ++half) {
        bf16x8 a[8], b[8];
#pragma unroll
        for (int s8 = 0; s8 < 8; ++s8) { a[s8] = *(const LAS bf16x8*)(kp + 16 * (8 * half + s8)); b[s8] = *(const LAS bf16x8*)(qp + 16 * (8 * half + s8)); }
#pragma unroll
        for (int s8 = 0; s8 < 8; ++s8) sc = __builtin_amdgcn_mfma_f32_32x32x16_bf16(a[s8], b[s8], sc, 0, 0, 0);
        __builtin_amdgcn_sched_barrier(0);
    }
#pragma unroll
    for (int q = 0; q < 4; ++q) {
        const int m0 = 8 * q + 4 * hh; float v[4];
#pragma unroll
        for (int i = 0; i < 4; ++i) v[i] = (m0 + i > r32) ? 0.f : sc[4 * q + i];
        u32x2 w; w.x = pk2(v[0], v[1]); w.y = pk2(v[2], v[3]);
        *(LAS u32x2*)(Ss + r32 * SC_SS + m0) = w;
    }
}
__device__ __forceinline__ void scan_scores16(const LAS bf16_t* Qs, const LAS bf16_t* Ks, LAS bf16_t* Ss, int lts, int mts, int g, int li) {
    f32x4 sc = {0.f, 0.f, 0.f, 0.f};
    const LAS bf16_t* kp = Ks + (16 * mts + li) * SC_KS + 8 * g; const LAS bf16_t* qp = Qs + (16 * lts + li) * SC_QS + 8 * g;
    bf16x8 a[8], b[8];
#pragma unroll
    for (int ks = 0; ks < 8; ++ks) { a[ks] = *(const LAS bf16x8*)(kp + 32 * ks); b[ks] = *(const LAS bf16x8*)(qp + 32 * ks); }
    f32x4 sc2 = {0.f, 0.f, 0.f, 0.f};
#pragma unroll
    for (int ks = 0; ks < 8; ks += 2) { sc = mfma16(a[ks], b[ks], sc); sc2 = mfma16(a[ks + 1], b[ks + 1], sc2); }
    sc = sc + sc2;
    const int l = 16 * lts + li;
#pragma unroll
    for (int i = 0; i < 4; ++i) if (16 * mts + 4 * g + i > l) sc[i] = 0.f;
    u32x2 w; w.x = pk2(sc[0], sc[1]); w.y = pk2(sc[2], sc[3]);
    *(LAS u32x2*)(Ss + l * SC_SS + 16 * mts + 4 * g) = w;
}
#define SCA_LDQ(F, kh) _Pragma("unroll") for (int k4 = 0; k4 < 4; ++k4) _Pragma("unroll") for (int l2 = 0; l2 < 2; ++l2) { \
        const LAS bf16_t* qp = Qs + (16 * l2 + li) * SC_QS + 32 * (4 * (kh) + k4) + 4 * g; F[2 * k4 + l2] = cat8(*(const LAS s16x4*)qp, *(const LAS s16x4*)(qp + 16)); }
__device__ __forceinline__ void scan_issue(bf16x8 (&F0)[8], bf16x8 (&F1)[8], bf16x8& vf, const LAS bf16_t* Qs, const LAS bf16_t* Vs, int wid, int g, int li) {
    const int q4 = li >> 2, p4 = li & 3;
    SCA_LDQ(F0, 0);
    vf = cat8(tr16(Vs + (4 * g + q4) * SC_VS + 16 * wid + 4 * p4), tr16(Vs + (16 + 4 * g + q4) * SC_VS + 16 * wid + 4 * p4));
    SCA_LDQ(F1, 1);
}
__device__ __forceinline__ void scan_main_a(f32x4 (&S)[16], f32x4 (&o)[2], bf16x8 (&F0)[8], bf16x8 (&F1)[8], const bf16x8 vf, const LAS bf16_t* Ks, int g, int li, float g32) {
    const int q4 = li >> 2, p4 = li & 3;
#define SCA_LDK(F, dh) _Pragma("unroll") for (int d8 = 0; d8 < 8; ++d8) { const int dt = 8 * (dh) + d8; \
        F[d8] = cat8(tr16(Ks + (4 * g + q4) * SC_KS + 16 * dt + 4 * p4), tr16(Ks + (16 + 4 * g + q4) * SC_KS + 16 * dt + 4 * p4)); }
#define SCA_CROSS(F, kh) _Pragma("unroll") for (int k4 = 0; k4 < 4; ++k4) { const int ks = 4 * (kh) + k4; \
        u32x4 aw; aw.x = pk2(S[2 * ks][0], S[2 * ks][1]); aw.y = pk2(S[2 * ks][2], S[2 * ks][3]); aw.z = pk2(S[2 * ks + 1][0], S[2 * ks + 1][1]); aw.w = pk2(S[2 * ks + 1][2], S[2 * ks + 1][3]); \
        const bf16x8 af = __builtin_bit_cast(bf16x8, aw); o[0] = mfma16(af, F[2 * k4], o[0]); o[1] = mfma16(af, F[2 * k4 + 1], o[1]); }
#define SCA_SUPD(F, dh) _Pragma("unroll") for (int d8 = 0; d8 < 8; ++d8) S[8 * (dh) + d8] = mfma16(F[d8], vf, S[8 * (dh) + d8]);
#pragma unroll
    for (int dt = 0; dt < 16; ++dt) S[dt] = S[dt] * g32;
    o[0] = (f32x4){0.f, 0.f, 0.f, 0.f}; o[1] = (f32x4){0.f, 0.f, 0.f, 0.f};
    __builtin_amdgcn_sched_barrier(0);
    SCA_CROSS(F0, 0);
    SCA_LDK(F0, 0);
    __builtin_amdgcn_sched_barrier(0);
    SCA_CROSS(F1, 1);
    SCA_LDK(F1, 1);
    __builtin_amdgcn_sched_barrier(0);
    SCA_SUPD(F0, 0);
    __builtin_amdgcn_sched_barrier(0);
    SCA_SUPD(F1, 1);
#undef SCA_LDK
#undef SCA_CROSS
#undef SCA_SUPD
}
#undef SCA_LDQ
__device__ __forceinline__ void scan_main_b(f32x4 (&o)[2], const bf16x8 vf, const LAS bf16_t* Ss, bf16_t* Vb, float* stat, size_t trow0, int ecol, int h, int wid, int g, int li, float log2g) {
#pragma unroll
    for (int l2 = 0; l2 < 2; ++l2) { const LAS bf16_t* sp_ = Ss + (16 * l2 + li) * SC_SS + 4 * g; const bf16x8 sb = cat8(*(const LAS s16x4*)sp_, *(const LAS s16x4*)(sp_ + 16)); o[l2] = mfma16(vf, sb, o[l2]); }
#pragma unroll
    for (int l2 = 0; l2 < 2; ++l2) {
        const int l = 16 * l2 + li; const float f = __builtin_amdgcn_exp2f((float)(l - 31) * log2g); const f32x4 v = o[l2] * f;
        const size_t trow = trow0 + l;
        u32x2 w; w.x = pk2(v[0], v[1]); w.y = pk2(v[2], v[3]);
        *(u32x2*)(Vb + trow * 2048 + ecol + 16 * wid + 4 * g) = w;
    }
}
struct ScanRegs { u32x4 q[4], k[4], v; };
__device__ __forceinline__ void scan_unit(LAS unsigned char* lds, const bf16_t* QK, bf16_t* Vb, float* stat, int row0, int nch, int h, int es, const float* S0, float* Sout, float log2g, int pmode = 0) {
    int tid_ = threadIdx.x; asm volatile("" : "+v"(tid_));
    const int tid = tid_, lane = tid & 63, wid = __builtin_amdgcn_readfirstlane(tid >> 6), g = lane >> 4, li = lane & 15;
    const bool loader = wid >= 4;
    const int lt = tid - 256;
    const int ecol = h * 512 + es * 32;
    const float g32 = exp2f(32.f * log2g);
#define SC_GLD(dst, ptr) asm volatile("global_load_dwordx4 %0, %1, off" : "=v"(dst) : "v"(ptr) : "memory")
#define SC_LOAD(c, R) do { const size_t rb = (size_t)(row0 + 32 * (c)); \
        _Pragma("unroll") for (int i = 0; i < 4; ++i) { const int id = lt + 256 * i, rr = id >> 5, cc = id & 31; const bf16_t* src = QK + (size_t)h * ((size_t)T * 256) + (rb + rr) * 256 + cc * 8; SC_GLD(R.q[i], src); SC_GLD(R.k[i], src + (size_t)4 * T * 256); } \
        { const int l2_ = lt & 127, rr = l2_ >> 2, cc = l2_ & 3; SC_GLD(R.v, Vb + (rb + rr) * 2048 + ecol + cc * 8); } } while (0)
#define SC_WAITV(n) asm volatile("s_waitcnt vmcnt(" #n ")" ::: "memory")
#define SC_SCALE(w, f) pk2(bflo(w) * (f), bfhi(w) * (f))
#define SC_WRITE(buf, R) do { LAS unsigned char* bb = lds + (buf) * SC_BUF; \
        _Pragma("unroll") for (int i = 0; i < 4; ++i) { const int id = lt + 256 * i, rr = id >> 5, cc = id & 31; \
            *(LAS u32x4*)(bb + SC_Q + (rr * SC_QS + cc * 8) * 2) = R.q[i]; *(LAS u32x4*)(bb + SC_K + (rr * SC_KS + cc * 8) * 2) = R.k[i]; } \
        if (lt < 128) { const int rr = lt >> 2, cc = lt & 3; const float vd = __builtin_amdgcn_exp2f((float)(31 - rr) * log2g); u32x4 vv; vv.x = SC_SCALE(R.v.x, vd); vv.y = SC_SCALE(R.v.y, vd); vv.z = SC_SCALE(R.v.z, vd); vv.w = SC_SCALE(R.v.w, vd); \
          *(LAS u32x4*)(bb + SC_V + (rr * SC_VS + cc * 8) * 2) = vv; } } while (0)
    LAS bf16_t* Ss = (LAS bf16_t*)(lds + SC_S);
    if (loader) {
        ScanRegs R0, R1, R2, R3;
        SC_LOAD(0, R0); SC_WAITV(0); __builtin_amdgcn_sched_barrier(0); SC_WRITE(0, R0);
        if (nch > 1) SC_LOAD(1, R1);
        if (nch > 2) SC_LOAD(2, R2);
        if (nch > 3) SC_LOAD(3, R3);
        __syncthreads();
#define SC_LSTEP(c, RFREE, RNEXT) do { if ((c) < nch) { if ((c) + 4 < nch && !(pmode & 2)) SC_LOAD((c) + 4, RFREE); \
            if (false) scan_scores((const LAS bf16_t*)(lds + ((c) & 1) * SC_BUF + SC_Q), (const LAS bf16_t*)(lds + ((c) & 1) * SC_BUF + SC_K), Ss, lane); \
            if ((c) + 4 < nch && !(pmode & 2)) SC_WAITV(27); else SC_WAITV(0); __builtin_amdgcn_sched_barrier(0); \
            if ((c) + 1 < nch && !(pmode & 2)) SC_WRITE(((c) + 1) & 1, RNEXT); __builtin_amdgcn_sched_barrier(0); __syncthreads(); } } while (0)
        for (int c = 0; c < nch; c += 4) { SC_LSTEP(c, R0, R1); SC_LSTEP(c + 1, R1, R2); SC_LSTEP(c + 2, R2, R3); SC_LSTEP(c + 3, R3, R0); }
#undef SC_LSTEP
    } else if (wid >= SC_NCW) {
        __syncthreads();
        for (int c = 0; c < nch; ++c) {
            const LAS bf16_t* Qs = (const LAS bf16_t*)(lds + (c & 1) * SC_BUF + SC_Q); const LAS bf16_t* Ks = (const LAS bf16_t*)(lds + (c & 1) * SC_BUF + SC_K);
            LAS bf16_t* Sc = (LAS bf16_t*)(lds + SC_S + (c & 1) * SC_SSZ);
            if (!(pmode & 4)) {
                if (wid == 2) { scan_scores16(Qs, Ks, Sc, 0, 0, g, li); scan_scores16(Qs, Ks, Sc, 1, 1, g, li); }
                else { scan_scores16(Qs, Ks, Sc, 1, 0, g, li); *(LAS u32x2*)(Sc + li * SC_SS + 16 + 4 * g) = (u32x2){0u, 0u}; }
            }
            __syncthreads();
        }
    } else {
        f32x4 S[16];
#pragma unroll
        for (int dt = 0; dt < 16; ++dt) S[dt] = (f32x4){0.f, 0.f, 0.f, 0.f};
        if (S0) {
            const float* sp = S0 + (size_t)(4 * g) * 512 + es * 32 + 16 * wid + li;
#pragma unroll
            for (int dt = 0; dt < 16; ++dt) {
#pragma unroll
                for (int i = 0; i < 4; ++i) S[dt][i] = sp[i * 512];
                sp += 16 * 512;
                if ((dt & 3) == 3) __builtin_amdgcn_sched_barrier(0);
            }
        }
        __syncthreads();
        bf16x8 F0[8], F1[8], vfn;
        scan_issue(F0, F1, vfn, (const LAS bf16_t*)(lds + SC_Q), (const LAS bf16_t*)(lds + SC_V), wid, g, li);
        for (int c = 0; c < nch; ++c) {
            const int cur = c & 1;
            const LAS bf16_t* Ks = (const LAS bf16_t*)(lds + cur * SC_BUF + SC_K);
            f32x4 o[2]; const bf16x8 vf = vfn;
            if (!(pmode & 1)) scan_main_a(S, o, F0, F1, vf, Ks, g, li, g32);
            __syncthreads();
            __builtin_amdgcn_sched_barrier(0);
            if (c + 1 < nch) scan_issue(F0, F1, vfn, (const LAS bf16_t*)(lds + (cur ^ 1) * SC_BUF + SC_Q), (const LAS bf16_t*)(lds + (cur ^ 1) * SC_BUF + SC_V), wid, g, li);
            __builtin_amdgcn_sched_barrier(0);
            if (!(pmode & 1)) scan_main_b(o, vf, (const LAS bf16_t*)(lds + SC_S + (c & 1) * SC_SSZ), Vb, stat, (size_t)(row0 + 32 * c), ecol, h, wid, g, li, log2g);
        }
        float* sp = Sout + (size_t)(4 * g) * 512 + es * 32 + 16 * wid + li;
#pragma unroll
        for (int dt = 0; dt < 16; ++dt) {
#pragma unroll
            for (int i = 0; i < 4; ++i) sp[i * 512] = S[dt][i];
            sp += 16 * 512;
            if ((dt & 3) == 3) __builtin_amdgcn_sched_barrier(0);
        }
    }
#undef SC_LOAD
#undef SC_GLD
#undef SC_WAITV
#undef SC_WRITE
#undef SC_SCALE
}

__device__ __forceinline__ void attn_wave(bf16_t* MQ, const bf16_t* Kb, const bf16_t* Vt, int t0, int h, int lane_) {
    int lane = lane_; asm volatile("" : "+v"(lane));
    const int g = lane >> 4, li = lane & 15;
    bf16x8 qf[8];
    bf16_t* qrow = MQ + (size_t)(t0 + li) * 1024 + h * 256;
#pragma unroll
    for (int ks = 0; ks < 8; ++ks) qf[ks] = *(const bf16x8*)(qrow + 32 * ks + 8 * g);
    f32x4 s[16];
#pragma unroll
    for (int mt = 0; mt < 16; ++mt) {
        s[mt] = (f32x4){0.f, 0.f, 0.f, 0.f};
        const bf16_t* kr = Kb + (size_t)(16 * mt + li) * 1024 + h * 256 + 8 * g;
#pragma unroll
        for (int ks = 0; ks < 8; ++ks) s[mt] = mfma16(*(const bf16x8*)(kr + 32 * ks), qf[ks], s[mt]);
    }
    float mx = -3.0e38f;
#pragma unroll
    for (int mt = 0; mt < 16; ++mt) mx = fmaxf(fmaxf(fmaxf(s[mt][0], s[mt][1]), fmaxf(s[mt][2], s[mt][3])), mx);
    mx = fmaxf(mx, __shfl_xor(mx, 16)); mx = fmaxf(mx, __shfl_xor(mx, 32));
    float sum = 0.f;
#pragma unroll
    for (int mt = 0; mt < 16; ++mt)
#pragma unroll
        for (int i = 0; i < 4; ++i) { const float p = __builtin_amdgcn_exp2f(s[mt][i] - mx); s[mt][i] = p; sum += p; }
    sum += __shfl_xor(sum, 16); sum += __shfl_xor(sum, 32);
    const float inv = 1.f / sum;
    bf16x8 pf[8];
#pragma unroll
    for (int k2 = 0; k2 < 8; ++k2) { u32x4 w; w.x = pk2(s[2 * k2][0], s[2 * k2][1]); w.y = pk2(s[2 * k2][2], s[2 * k2][3]); w.z = pk2(s[2 * k2 + 1][0], s[2 * k2 + 1][1]); w.w = pk2(s[2 * k2 + 1][2], s[2 * k2 + 1][3]); pf[k2] = __builtin_bit_cast(bf16x8, w); }
#pragma unroll 4
    for (int dt = 0; dt < 16; ++dt) {
        f32x4 o = {0.f, 0.f, 0.f, 0.f};
        const bf16_t* vr = Vt + (size_t)(h * 256 + 16 * dt + li) * 256 + 8 * g;
#pragma unroll
        for (int k2 = 0; k2 < 8; ++k2) o = mfma16(*(const bf16x8*)(vr + 32 * k2), pf[k2], o);
        o = o * inv; u32x2 w; w.x = pk2(o[0], o[1]); w.y = pk2(o[2], o[3]);
        *(u32x2*)(qrow + 16 * dt + 4 * g) = w;
    }
}

constexpr int AT_ST = 264;
static_assert(256 * AT_ST * 2 <= LDS_CTLOFF, "attention K/V tile fits below the LDS control words");
__device__ __forceinline__ void attn_unit_lds(LAS unsigned char* lds, bf16_t* MQ, const bf16_t* Kb, const bf16_t* Vt, int tblk, int h) {
    int tid_ = threadIdx.x; asm volatile("" : "+v"(tid_));
    const int tid = tid_, lane = tid & 63, wave = __builtin_amdgcn_readfirstlane(tid >> 6), g = lane >> 4, li = lane & 15;
    LAS bf16_t* T = (LAS bf16_t*)lds;
    u32x4 st[16];
#pragma unroll
    for (int i = 0; i < 16; ++i) { const int id = tid + 512 * i, row = id >> 5, cc = id & 31; st[i] = *(const u32x4*)(Kb + (size_t)row * 1024 + h * 256 + cc * 8); }
    bf16x8 qf[8];
    bf16_t* qrow = MQ + (size_t)(tblk + 16 * wave + li) * 1024 + h * 256;
#pragma unroll
    for (int ks = 0; ks < 8; ++ks) qf[ks] = *(const bf16x8*)(qrow + 32 * ks + 8 * g);
    __syncthreads();
#pragma unroll
    for (int i = 0; i < 16; ++i) { const int id = tid + 512 * i, row = id >> 5, cc = id & 31; *(LAS u32x4*)(T + row * AT_ST + cc * 8) = st[i]; }
#pragma unroll
    for (int i = 0; i < 16; ++i) { const int id = tid + 512 * i, row = id >> 5, cc = id & 31; st[i] = *(const u32x4*)(Vt + (size_t)(h * 256 + row) * 256 + cc * 8); }
    __syncthreads();
    f32x4 s[16];
#pragma unroll
    for (int mt = 0; mt < 16; ++mt) {
        s[mt] = (f32x4){0.f, 0.f, 0.f, 0.f};
        const LAS bf16_t* kr = T + (16 * mt + li) * AT_ST + 8 * g;
        bf16x8 kf[8];
#pragma unroll
        for (int ks = 0; ks < 8; ++ks) kf[ks] = *(const LAS bf16x8*)(kr + 32 * ks);
#pragma unroll
        for (int ks = 0; ks < 8; ++ks) s[mt] = mfma16(kf[ks], qf[ks], s[mt]);
    }
    float mx = -3.0e38f;
#pragma unroll
    for (int mt = 0; mt < 16; ++mt) mx = fmaxf(fmaxf(fmaxf(s[mt][0], s[mt][1]), fmaxf(s[mt][2], s[mt][3])), mx);
    mx = fmaxf(mx, __shfl_xor(mx, 16)); mx = fmaxf(mx, __shfl_xor(mx, 32));
    float sum = 0.f;
#pragma unroll
    for (int mt = 0; mt < 16; ++mt)
#pragma unroll
        for (int i = 0; i < 4; ++i) { const float p = __builtin_amdgcn_exp2f(s[mt][i] - mx); s[mt][i] = p; sum += p; }
    sum += __shfl_xor(sum, 16); sum += __shfl_xor(sum, 32);
    const float inv = 1.f / sum;
    bf16x8 pf[8];
#pragma unroll
    for (int k2 = 0; k2 < 8; ++k2) { u32x4 w; w.x = pk2(s[2 * k2][0], s[2 * k2][1]); w.y = pk2(s[2 * k2][2], s[2 * k2][3]); w.z = pk2(s[2 * k2 + 1][0], s[2 * k2 + 1][1]); w.w = pk2(s[2 * k2 + 1][2], s[2 * k2 + 1][3]); pf[k2] = __builtin_bit_cast(bf16x8, w); }
    __syncthreads();
#pragma unroll
    for (int i = 0; i < 16; ++i) { const int id = tid + 512 * i, row = id >> 5, cc = id & 31; *(LAS u32x4*)(T + row * AT_ST + cc * 8) = st[i]; }
    __syncthreads();
#pragma unroll 4
    for (int dt = 0; dt < 16; ++dt) {
        f32x4 o = {0.f, 0.f, 0.f, 0.f};
        const LAS bf16_t* vr = T + (16 * dt + li) * AT_ST + 8 * g;
        bf16x8 vf[8];
#pragma unroll
        for (int k2 = 0; k2 < 8; ++k2) vf[k2] = *(const LAS bf16x8*)(vr + 32 * k2);
#pragma unroll
        for (int k2 = 0; k2 < 8; ++k2) o = mfma16(vf[k2], pf[k2], o);
        o = o * inv; u32x2 w; w.x = pk2(o[0], o[1]); w.y = pk2(o[2], o[3]);
        *(u32x2*)(qrow + 16 * dt + 4 * g) = w;
    }
}

__device__ __forceinline__ void unpack8(const u32x4 w, float (&f)[8]) { f[0] = bflo(w.x); f[1] = bfhi(w.x); f[2] = bflo(w.y); f[3] = bfhi(w.y); f[4] = bflo(w.z); f[5] = bfhi(w.z); f[6] = bflo(w.w); f[7] = bfhi(w.w); }
__device__ __forceinline__ void load8f(const float* p, float (&f)[8]) { const f32x4 a = *(const f32x4*)p, b = *(const f32x4*)(p + 4); f[0] = a[0]; f[1] = a[1]; f[2] = a[2]; f[3] = a[3]; f[4] = b[0]; f[5] = b[1]; f[6] = b[2]; f[7] = b[3]; }
__device__ __forceinline__ void conv_item(int item, bf16_t* CB, const bf16_t* P, const float* wc, const float* st_s, float* outP, float* outS) {
    const int rg = item >> 7, c = (item & 127) * 8, r0 = rg * 8;
    float w0[8], w1[8], w2[8], h2[8], h1[8];
    load8f(wc + c, w0); load8f(wc + 1024 + c, w1); load8f(wc + 2048 + c, w2);
    if (tok_batch_start(r0)) {
        if (r0 < TP) {
#pragma unroll
            for (int k = 0; k < 8; ++k) { h2[k] = 0.f; h1[k] = 0.f; }
        } else { const float* sp = st_s + (size_t)((r0 - TP) >> 5) * 2048 + c; load8f(sp, h2); load8f(sp + 1024, h1); }
    } else { unpack8(*(const u32x4*)(P + (size_t)(r0 - 2) * 1024 + c), h2); unpack8(*(const u32x4*)(P + (size_t)(r0 - 1) * 1024 + c), h1); }
    u32x4 pw[8], bw[8];
#pragma unroll
    for (int i = 0; i < 8; ++i) { pw[i] = *(const u32x4*)(P + (size_t)(r0 + i) * 1024 + c); bw[i] = *(const u32x4*)(CB + (size_t)(r0 + i) * 1024 + c); }
#pragma unroll
    for (int i = 0; i < 8; ++i) {
        const int r = r0 + i; float p[8], b[8], y[8];
        unpack8(pw[i], p); unpack8(bw[i], b);
#pragma unroll
        for (int k = 0; k < 8; ++k) y[k] = b[k] * (w0[k] * h2[k] + w1[k] * h1[k] + w2[k] * p[k]);
        u32x4 o; o.x = pk2(y[0], y[1]); o.y = pk2(y[2], y[3]); o.z = pk2(y[4], y[5]); o.w = pk2(y[6], y[7]);
        *(u32x4*)(CB + (size_t)r * 1024 + c) = o;
        float* so = nullptr;
        if (r < TP) { const int t = r & 8191; if (t >= 8190) so = outP + ((size_t)(r >> 13) * 2 + (t - 8190)) * 1024; }
        else { const int t = (r - TP) & 31; if (t >= 30) so = outS + ((size_t)((r - TP) >> 5) * 2 + (t - 30)) * 1024; }
        if (so) { *(f32x4*)(so + c) = (f32x4){p[0], p[1], p[2], p[3]}; *(f32x4*)(so + c + 4) = (f32x4){p[4], p[5], p[6], p[7]}; }
#pragma unroll
        for (int k = 0; k < 8; ++k) { h2[k] = h1[k]; h1[k] = p[k]; }
    }
}
__device__ __forceinline__ void act_item(int item, const bf16_t* A, bf16_t* U, const float* wc, const float* st_s, bool do_store = true) {
    const int rg = item / 352, c = (item - rg * 352) * 8, r0 = rg * 8;
    float w0[8], w1[8], w2[8], h2[8], h1[8];
    load8f(wc + c, w0); load8f(wc + DFF + c, w1); load8f(wc + 2 * DFF + c, w2);
    if (tok_batch_start(r0)) {
        if (r0 < TP) {
#pragma unroll
            for (int k = 0; k < 8; ++k) { h2[k] = 0.f; h1[k] = 0.f; }
        } else { const float* sp = st_s + (size_t)((r0 - TP) >> 5) * 2 * DFF + c; load8f(sp, h2); load8f(sp + DFF, h1); }
    } else { unpack8(*(const u32x4*)(A + (size_t)(r0 - 2) * DFF + c), h2); unpack8(*(const u32x4*)(A + (size_t)(r0 - 1) * DFF + c), h1); }
    u32x4 aw[8], uw[8];
#pragma unroll
    for (int i = 0; i < 8; ++i) { aw[i] = *(const u32x4*)(A + (size_t)(r0 + i) * DFF + c); uw[i] = *(const u32x4*)(U + (size_t)(r0 + i) * DFF + c); }
#pragma unroll
    for (int i = 0; i < 8; ++i) {
        float a[8], u[8], y[8];
        unpack8(aw[i], a); unpack8(uw[i], u);
#pragma unroll
        for (int k = 0; k < 8; ++k) y[k] = silu_f(w0[k] * h2[k] + w1[k] * h1[k] + w2[k] * a[k]) * u[k];
        u32x4 o; o.x = pk2(y[0], y[1]); o.y = pk2(y[2], y[3]); o.z = pk2(y[4], y[5]); o.w = pk2(y[6], y[7]);
        if (do_store) *(u32x4*)(U + (size_t)(r0 + i) * DFF + c) = o;
#pragma unroll
        for (int k = 0; k < 8; ++k) { h2[k] = h1[k]; h1[k] = a[k]; }
    }
}

__device__ __forceinline__ f32x4 skinny_gemm(LAS unsigned char* lds, const bf16_t* Act, int K, const bf16_t* Wt, int n0, int rq, int wave, int lane_) {
    int lane = lane_; asm volatile("" : "+v"(lane));
    const int g = lane >> 4, li = lane & 15, K8 = K >> 3, nk = K8 >> 5;
    const bf16_t* wp = Wt + (size_t)(n0 + li) * K + wave * K8 + 8 * g;
    const bf16_t* ap = Act + (size_t)(64 * rq + li) * K + wave * K8 + 8 * g;
    f32x4 acc[4];
#pragma unroll
    for (int t = 0; t < 4; ++t) acc[t] = (f32x4){0.f, 0.f, 0.f, 0.f};
    for (int k0 = 0; k0 < nk; k0 += 4) {
        bf16x8 wf[4], xf[4][4];
#pragma unroll
        for (int j = 0; j < 4; ++j) if (k0 + j < nk) {
            wf[j] = *(const bf16x8*)(wp + 32 * (k0 + j));
#pragma unroll
            for (int t = 0; t < 4; ++t) xf[j][t] = *(const bf16x8*)(ap + (size_t)(16 * t) * K + 32 * (k0 + j));
        }
#pragma unroll
        for (int j = 0; j < 4; ++j) if (k0 + j < nk) {
#pragma unroll
            for (int t = 0; t < 4; ++t) acc[t] = mfma16(wf[j], xf[j][t], acc[t]);
        }
    }
    LAS f32x4* xch = (LAS f32x4*)(lds + 65536);
    __syncthreads();
#pragma unroll
    for (int t = 0; t < 4; ++t) xch[(wave * 4 + t) * 64 + lane] = acc[t];
    __syncthreads();
    f32x4 r = {0.f, 0.f, 0.f, 0.f};
    if (wave < 4) {
#pragma unroll
        for (int w = 0; w < 8; ++w) r = r + xch[(w * 4 + wave) * 64 + lane];
    }
    return r;
}
#define XB_TMO      128
#define XB_XCNT(j)  (256  + 64 * (j))
#define XB_XSUB(j)  (1280 + 64 * (j))
#define XB_XGEN(j)  (2304 + 64 * (j))
#define XB_TOP      3328
#define XB_TOPGEN   3392
#define XCD_BAR_WORDS 3456
#define XB_SPIN_CAP (1u << 18)

__device__ __forceinline__ unsigned xb_ld(unsigned* p)              { return __hip_atomic_load(p, __ATOMIC_RELAXED, __HIP_MEMORY_SCOPE_AGENT); }
__device__ __forceinline__ unsigned xb_add(unsigned* p, unsigned v) { return __hip_atomic_fetch_add(p, v, __ATOMIC_RELAXED, __HIP_MEMORY_SCOPE_AGENT); }
__device__ __forceinline__ unsigned xb_xcc_id() { return (unsigned)__builtin_amdgcn_s_getreg((3 << 11) | 20) & 0xFu; }
#define XB_SPIN(cond, bar) do { unsigned _sp = 0; while (cond) { __builtin_amdgcn_s_sleep(1); \
    if ((++_sp & 255u) == 0u) { if (xb_ld(&(bar)[XB_TMO])) break; if (_sp > XB_SPIN_CAP) { atomicAdd(&(bar)[XB_TMO], 1u); break; } } } } while (0)

struct XcdBarrier {
    unsigned* bar; unsigned x;
    volatile __attribute__((address_space(3))) unsigned* st;
};

__device__ __forceinline__ XcdBarrier xcd_barrier_post(unsigned* bar, volatile __attribute__((address_space(3))) unsigned* st) {
    XcdBarrier b; b.bar = bar; b.x = xb_xcc_id(); b.st = st;
    if (threadIdx.x == 0) (void)xb_add(&bar[XB_XCNT(b.x)], 1u);
    return b;
}
__device__ __forceinline__ void xcd_barrier_complete(unsigned* bar, unsigned x, unsigned& nloc, unsigned& nx) {
    const unsigned G = gridDim.x * gridDim.y * gridDim.z;
    unsigned sum, cnt, mine, sp = 0u;
    for (;;) {
        sum = 0u; cnt = 0u; mine = 0u;
#pragma unroll
        for (unsigned j = 0; j < 16; ++j) { const unsigned c = xb_ld(&bar[XB_XCNT(j)]); sum += c; cnt += (c > 0u) ? 1u : 0u; mine = (j == x) ? c : mine; }
        if (sum == G) break;
        __builtin_amdgcn_s_sleep(1);
        if ((++sp & 255u) == 0u) { if (xb_ld(&bar[XB_TMO])) break; if (sp > XB_SPIN_CAP) { atomicAdd(&bar[XB_TMO], 1u); break; } }
    }
    nloc = mine > 0u ? mine : 1u; nx = cnt > 0u ? cnt : 1u;
}

__device__ __forceinline__ void xcd_barrier(const XcdBarrier& b) {
    asm volatile("s_waitcnt vmcnt(0)" ::: "memory");
    __syncthreads();
    if (threadIdx.x == 0) {
        unsigned* bar = b.bar;
        __builtin_amdgcn_s_waitcnt(0);
        unsigned nloc = b.st[0], nx = b.st[1];
        if (nloc == 0u) { xcd_barrier_complete(bar, b.x, nloc, nx); b.st[0] = nloc; b.st[1] = nx; }
        const unsigned old = xb_add(&bar[XB_XSUB(b.x)], 1u);
        const unsigned gen = old / nloc;
        if (old + 1u == (gen + 1u) * nloc) {
            __builtin_amdgcn_fence(__ATOMIC_RELEASE, "agent");
            asm volatile("s_waitcnt vmcnt(0)" ::: "memory");
            const unsigned og = xb_add(&bar[XB_TOP], 1u);
            const unsigned tg = og / nx;
            if (og + 1u == (tg + 1u) * nx) xb_add(&bar[XB_TOPGEN], 1u);
            else XB_SPIN(xb_ld(&bar[XB_TOPGEN]) == tg, bar);
            __builtin_amdgcn_fence(__ATOMIC_ACQUIRE, "agent");
            xb_add(&bar[XB_XGEN(b.x)], 1u);
            asm volatile("s_waitcnt vmcnt(0)" ::: "memory");
        } else {
            XB_SPIN(xb_ld(&bar[XB_XGEN(b.x)]) == gen, bar);
            __builtin_amdgcn_fence(__ATOMIC_ACQUIRE, "agent");
            asm volatile("s_waitcnt vmcnt(0)" ::: "memory");
        }
    }
    __syncthreads();
}

__global__ void __launch_bounds__(512, 2) fwd_megakernel(Args args) {
    extern __shared__ __attribute__((aligned(16))) unsigned char lds_raw[];
    LAS unsigned char* lds = (LAS unsigned char*)lds_raw;
    cg::grid_group grid = cg::this_grid();
    { volatile LAS unsigned* z = (volatile LAS unsigned*)(lds + LDS_CTLOFF); if (threadIdx.x < 16) z[threadIdx.x] = 0u; __syncthreads(); }
    if (args.out == nullptr) grid.sync();
    const XcdBarrier xbar = xcd_barrier_post((unsigned*)(args.ws + WS_CTL + CTL_XBAR), (volatile LAS unsigned*)(lds + LDS_CTLOFF + 16));
    const int G = gridDim.x, blk = blockIdx.x, NGW = G * 8;
#define PHASE_IDS() int tid_ = threadIdx.x; asm volatile("" : "+v"(tid_)); const int tid = tid_, lane = tid & 63, wave = __builtin_amdgcn_readfirstlane(tid >> 6), gw = blk * 8 + wave; (void)gw; (void)lane; (void)tid
    unsigned char* ws = args.ws; float* out = args.out;
    const float* x_prompt = args.in[0]; const float* x_sample = args.in[1]; const float* mem_prompt = args.in[2]; const float* state_ret = args.in[3];
    const float* state_conv = args.in[4]; const float* state_ffn = args.in[5]; const float* cache_k = args.in[6]; const float* cache_v = args.in[7];
    const float* g_mix = args.in[8]; const float* w_in = args.in[9]; const float* g_ret_gn = args.in[10]; const float* w_conv = args.in[11]; const float* g_mem = args.in[12];
    const float* w_mem_kv = args.in[13]; const float* w_br_ret = args.in[14]; const float* w_br_conv = args.in[15]; const float* w_br_mem = args.in[16]; const float* w_out = args.in[17];
    const float* g_ffn = args.in[18]; const float* w_ffn_in = args.in[19]; const float* w_ffn_conv = args.in[20]; const float* w_ffn_down = args.in[21]; const float* g_final = args.in[22];
    bf16_t* FFNIN = (bf16_t*)(ws + WS_FFNIN); bf16_t* FFNDN = (bf16_t*)(ws + WS_FFNDN); bf16_t* WOUT = (bf16_t*)(ws + WS_WOUT); bf16_t* BRRET = (bf16_t*)(ws + WS_BRRET);
    bf16_t* BRCONV = (bf16_t*)(ws + WS_BRCONV); bf16_t* BRMEM = (bf16_t*)(ws + WS_BRMEM); bf16_t* WIN = (bf16_t*)(ws + WS_WIN); bf16_t* WMEMKV = (bf16_t*)(ws + WS_WMEMKV);
    bf16_t* HN = (bf16_t*)(ws + WS_HN); bf16_t* Vb = (bf16_t*)(ws + WS_V); bf16_t* CB = (bf16_t*)(ws + WS_CB); bf16_t* Pb = (bf16_t*)(ws + WS_P); bf16_t* MQ = (bf16_t*)(ws + WS_MQ);
    bf16_t* MKB = (bf16_t*)(ws + WS_MKB); bf16_t* MVT = (bf16_t*)(ws + WS_MVT); bf16_t* MERGED = (bf16_t*)(ws + WS_MERGED);
    bf16_t* X1B = (bf16_t*)(ws + WS_X1B); bf16_t* ABUF = (bf16_t*)(ws + WS_ABUF); bf16_t* UBUF = (bf16_t*)(ws + WS_UBUF);
    unsigned* queue = (unsigned*)(ws + WS_CTL + CTL_QUEUE); float* SS1 = (float*)(ws + WS_CTL + CTL_SS1); float* SS2 = (float*)(ws + WS_CTL + CTL_SS2); float* STAT = (float*)(ws + WS_CTL + CTL_STAT);
    bf16_t* QK = (bf16_t*)out;
    bf16_t* ORNB = (bf16_t*)out; bf16_t* STASH = Vb; float* X1 = out + O_Y;
    bf16_t* MEMN = (bf16_t*)(out + O_RETS);

    for (int rep_ = 0; rep_ < REP_P0; ++rep_)
    {
        PHASE_IDS(); LAS float* scr = (LAS float*)(lds + wave * 16384);
        constexpr int I_WIN = 16 * 416, I_MKV = 16 * 64, I_RET = 32 * 32, I_SQ = 16 * 32, I_CV = 8 * 4 * 32;
        constexpr int NIT = I_WIN + I_MKV + I_RET + 3 * I_SQ + I_CV;
        for (int it = gw; it < NIT; it += NGW) {
            int r = it;
            if (r < I_WIN) { const int kb = r / 416, nb = r % 416; transpose_item<false>(w_in, 13312, WIN, 1024, 64 * kb, 32 * nb, map_win(32 * nb), nullptr, scr, lane); continue; } r -= I_WIN;
            if (r < I_MKV) { const int kb = r / 64, nb = r % 64; transpose_item<false>(w_mem_kv, 2048, WMEMKV, 1024, 64 * kb, 32 * nb, 32 * nb, nullptr, scr, lane); continue; } r -= I_MKV;
            if (r < I_RET) { const int kb = r / 32, nb = r % 32; transpose_item<false>(w_br_ret, 1024, BRRET, 2048, 64 * kb, 32 * nb, 32 * nb, nullptr, scr, lane); continue; } r -= I_RET;
            if (r < I_SQ) { const int kb = r / 32, nb = r % 32; transpose_item<false>(w_br_conv, 1024, BRCONV, 1024, 64 * kb, 32 * nb, 32 * nb, nullptr, scr, lane); continue; } r -= I_SQ;
            if (r < I_SQ) { const int kb = r / 32, nb = r % 32; transpose_item<false>(w_br_mem, 1024, BRMEM, 1024, 64 * kb, 32 * nb, 32 * nb, nullptr, scr, lane); continue; } r -= I_SQ;
            if (r < I_SQ) { const int kb = r / 32, nb = r % 32; transpose_item<false>(w_out, 1024, WOUT, 1024, 64 * kb, 32 * nb, 32 * nb, nullptr, scr, lane); continue; } r -= I_SQ;
            { const int b = r / 128, q = r % 128, kb = q / 32, nb = q % 32;
              transpose_item<true>(cache_v + (size_t)b * 262144, 1024, MVT + (size_t)(2 + b) * 262144, 256, 64 * kb, 32 * nb, 32 * nb, nullptr, scr, lane); }
        }
        for (int m = gw; m < T; m += 2 * NGW) {
            const int m2 = m + NGW; const bool two = m2 < T;
            const float* xa = m < TP ? x_prompt + (size_t)m * 1024 : x_sample + (size_t)(m - TP) * 1024;
            const float* xb = !two ? xa : (m2 < TP ? x_prompt + (size_t)m2 * 1024 : x_sample + (size_t)(m2 - TP) * 1024);
            f32x4 va[4], vb[4]; float sa = 0.f, sb = 0.f;
#pragma unroll
            for (int j = 0; j < 4; ++j) { va[j] = ((const f32x4*)xa)[lane + 64 * j]; vb[j] = ((const f32x4*)xb)[lane + 64 * j]; }
#pragma unroll
            for (int j = 0; j < 4; ++j) { sa += (va[j][0] * va[j][0] + va[j][1] * va[j][1]) + (va[j][2] * va[j][2] + va[j][3] * va[j][3]); sb += (vb[j][0] * vb[j][0] + vb[j][1] * vb[j][1]) + (vb[j][2] * vb[j][2] + vb[j][3] * vb[j][3]); }
            const float ra = rsqrtf(wave_sum(sa) * (1.f / 1024.f) + EPS), rb = rsqrtf(wave_sum(sb) * (1.f / 1024.f) + EPS);
#pragma unroll
            for (int j = 0; j < 4; ++j) { const f32x4 gg = ((const f32x4*)g_mix)[lane + 64 * j];
                u32x2 w; w.x = pk2(va[j][0] * ra * gg[0], va[j][1] * ra * gg[1]); w.y = pk2(va[j][2] * ra * gg[2], va[j][3] * ra * gg[3]); ((u32x2*)(HN + (size_t)m * 1024))[lane + 64 * j] = w;
                if (two) { u32x2 w2; w2.x = pk2(vb[j][0] * rb * gg[0], vb[j][1] * rb * gg[1]); w2.y = pk2(vb[j][2] * rb * gg[2], vb[j][3] * rb * gg[3]); ((u32x2*)(HN + (size_t)m2 * 1024))[lane + 64 * j] = w2; } }
        }
        for (int m = gw; m < 512; m += NGW) row_norm_bf16(mem_prompt + (size_t)m * 1024, g_mem, MEMN + (size_t)m * 1024, lane, true);
        for (int m = gw; m < 2048; m += NGW) row_norm_bf16(cache_k + (size_t)m * 1024, nullptr, MKB + (size_t)(512 + m) * 1024, lane, false);
    }
    xcd_barrier(xbar);

#ifndef SCAN_PROBE_MODE
#define SCAN_PROBE_MODE 0
#endif
#ifndef REP_SK3
#define REP_SK3 1
#endif
#ifndef XBAR_TWICE
#define XBAR_TWICE 0
#endif
#ifndef REP_P12
#define REP_P12 0
#endif
#ifndef P2_MASK_FIRST
#define P2_MASK_FIRST 15
#endif
    for (int rep12_ = 0; rep12_ <= REP_P12; ++rep12_) {
    if (rep12_) { PHASE_IDS(); for (int i_ = blk * 512 + tid; i_ < T * 8; i_ += G * 512) STAT[i_] = 0.f; if (blk == 0 && tid < 3) queue[64 * tid] = 0u; xcd_barrier(xbar); }
#ifndef SKIP_P1
    for (int rep_ = 0; rep_ < REP_P1; ++rep_)
    {
        pg8::Gemm g{HN, WIN, T, 8192, 1024}; pg8::StaticOrder S; S.init(T, 8192, G, blk);
        EpiZ1a E{QK, Vb, CB, Pb, MQ};
        pg8::gemm_phase<EpiZ1a, pg8::StaticOrder, true, true>(lds, g, S, E);
        if (rep12_ == 0) {
        pg8::Gemm g2{MEMN, WMEMKV, 512, 2048, 1024}; pg8::StaticOrder S2; S2.init(512, 2048, G, (blk + G - 32) % G);
        EpiMemKV E2{out + O_MKP, out + O_MVP, MKB, MVT};
        pg8::gemm_phase<EpiMemKV, pg8::StaticOrder, true, true>(lds, g2, S2, E2);
        }
    }
#endif
    xcd_barrier(xbar); if (XBAR_TWICE) xcd_barrier(xbar);

#ifndef SKIP_P2
    {
        PHASE_IDS();
        LAS volatile int* qs = (LAS volatile int*)(lds + LDS_CTLOFF);
        constexpr int U_SCANP = 128, U_SCANS = 512, U_ATT = 520, U_CONV = 520;
#define QUEUE_NEXT(word, uu) do { if (tid == 0) *qs = (int)atomicAdd(queue + (word), 1u); __syncthreads(); uu = *qs; __syncthreads(); } while (0)
        for (;;) {
            int uu; QUEUE_NEXT(0, uu);
            if (uu >= U_SCANP + U_SCANS) break;
            if (REP_P12 && rep12_ == 0 && !((P2_MASK_FIRST >> (uu < U_SCANP ? 0 : 1)) & 1)) continue;
            int row0, nch, h, es; const float* S0; float* So;
            if (uu < U_SCANP) { const int bh = uu >> 4; es = uu & 15; h = bh & 3; row0 = (bh >> 2) * 8192; nch = 256; S0 = nullptr; So = out + O_RETP + (size_t)bh * 131072; }
            else { const int v = uu - U_SCANP, bh = v >> 4; es = v & 15; h = bh & 3; row0 = TP + (bh >> 2) * 32; nch = 1; S0 = state_ret + (size_t)bh * 131072; So = out + O_RETS + (size_t)bh * 131072; }
            const float log2g = log2f(1.f - exp2f(-5.f - (float)h));
            { int pm_ = 0; if (REP_P12 && rep12_ == 0) { pm_ = SCAN_PROBE_MODE & 7; if (SCAN_PROBE_MODE & 8) nch = nch > 1 ? nch / 2 : 1; }
              scan_unit(lds, QK, Vb, STAT, row0, nch, h, es, S0, So, log2g, pm_); }
        }
        for (;;) {
            int uu; QUEUE_NEXT(64, uu);
            if (uu >= U_ATT) break;
            if (REP_P12 && rep12_ == 0 && !((P2_MASK_FIRST >> 2) & 1)) continue;
            const int tile = 129 - (uu >> 2), h = uu & 3, t0 = tile * 128 + wave * 16;
            const int bb = t0 < TP ? (t0 >> 13) : 2 + ((t0 - TP) >> 5);
            if (tile < 128) attn_unit_lds(lds, MQ, MKB + (size_t)bb * 262144, MVT + (size_t)bb * 262144, tile * 128, h);
            else attn_wave(MQ, MKB + (size_t)bb * 262144, MVT + (size_t)bb * 262144, t0, h, lane);
        }
        for (;;) {
            int uu; QUEUE_NEXT(128, uu);
            if (uu >= U_CONV) break;
            if (REP_P12 && rep12_ == 0 && !((P2_MASK_FIRST >> 3) & 1)) continue;
            { int t2 = tid; asm volatile("" : "+v"(t2)); conv_item(uu * 512 + t2, CB, Pb, w_conv, state_conv, out + O_CONVP, out + O_CONVS); }
        }
#undef QUEUE_NEXT
    }
#endif
    xcd_barrier(xbar); if (XBAR_TWICE) xcd_barrier(xbar);

    }
#ifdef PROBE_P2B
    { PHASE_IDS(); LAS float* scr = (LAS float*)(lds + wave * 16384);
      for (int it = gw; it < 16 * 176 + 44 * 32; it += NGW) {
            if (it < 16 * 176) { const int kb = it / 176, nb = it % 176; transpose_item<false>(w_ffn_in, 5632, FFNIN, 1024, 64 * kb, 32 * nb, map_ffn(32 * nb), g_ffn, scr, lane); }
            else { const int r = it - 16 * 176, kb = r / 32, nb = r % 32; transpose_item<false>(w_ffn_down, 1024, FFNDN, DFF, 64 * kb, 32 * nb, 32 * nb, nullptr, scr, lane); } }
      __syncthreads();
      pg8::Gemm g{HN, WIN + (size_t)8192 * 1024, T, 2048, 1024}; pg8::StaticOrder S; S.init(T, 2048, G, blk); EpiNull E{queue + 200, SS2};
      pg8::gemm_phase<EpiNull, pg8::StaticOrder, true, true>(lds, g, S, E); }
#endif
#ifndef SKIP_P2B
    {
        PHASE_IDS(); LAS float* scr = (LAS float*)(lds + wave * 16384);
        constexpr int I_FIN = 16 * 176, I_FDN = 44 * 32;
        for (int it = gw; it < I_FIN + I_FDN; it += NGW) {
            if (it < I_FIN) { const int kb = it / 176, nb = it % 176; transpose_item<false>(w_ffn_in, 5632, FFNIN, 1024, 64 * kb, 32 * nb, map_ffn(32 * nb), g_ffn, scr, lane); }
            else { const int r = it - I_FIN, kb = r / 32, nb = r % 32; transpose_item<false>(w_ffn_down, 1024, FFNDN, DFF, 64 * kb, 32 * nb, 32 * nb, nullptr, scr, lane); }
        }
        for (int pc_ = blk; pc_ < 512; pc_ += G) {
            const int strip = pc_ >> 2, n0 = 16 * strip, rq = pc_ & 3, h_ = strip >> 5, g4 = lane >> 4, li = lane & 15;
            LAS float* sst = (LAS float*)(lds + 32768);
            __syncthreads();
            {
                u32x4 w_[8];
#pragma unroll
                for (int k8 = 0; k8 < 8; ++k8) w_[k8] = *(const u32x4*)(Vb + (size_t)(TP + 64 * rq + wave + 8 * k8) * 2048 + h_ * 512 + lane * 8);
#pragma unroll
                for (int k8 = 0; k8 < 8; ++k8) {
                    const int rr_ = wave + 8 * k8;
                    const float a0_ = bflo(w_[k8].x), a1_ = bfhi(w_[k8].x), a2_ = bflo(w_[k8].y), a3_ = bfhi(w_[k8].y), a4_ = bflo(w_[k8].z), a5_ = bfhi(w_[k8].z), a6_ = bflo(w_[k8].w), a7_ = bfhi(w_[k8].w);
                    float s1_ = ((a0_ + a1_) + (a2_ + a3_)) + ((a4_ + a5_) + (a6_ + a7_)), s2_ = ((a0_ * a0_ + a1_ * a1_) + (a2_ * a2_ + a3_ * a3_)) + ((a4_ * a4_ + a5_ * a5_) + (a6_ * a6_ + a7_ * a7_));
                    s1_ = wave_sum(s1_); s2_ = wave_sum(s2_);
                    if (lane == 0) { sst[2 * rr_] = s1_; sst[2 * rr_ + 1] = s2_; }
                }
            }
            const f32x4 ac = skinny_gemm(lds, HN + (size_t)TP * 1024, 1024, WIN + (size_t)8192 * 1024, n0, rq, wave, lane);
            if (wave < 4) {
                const int rl = 16 * wave + li; const size_t po = (size_t)(TP + 64 * rq + rl) * 2048 + n0 + 4 * g4;
                const float mu = sst[2 * rl] * (1.f / 512.f), var = fmaxf(sst[2 * rl + 1] * (1.f / 512.f) - mu * mu, 0.f), rstd = rsqrtf(var + EPS);
                const u32x2 ov = *(const u32x2*)(Vb + po); const f32x4 gv = *(const f32x4*)(g_ret_gn + n0 + 4 * g4);
                const float o0 = bflo(ov.x), o1 = bfhi(ov.x), o2 = bflo(ov.y), o3 = bfhi(ov.y);
                u32x2 w; w.x = pk2((o0 - mu) * rstd * gv[0] * silu_f(ac[0]), (o1 - mu) * rstd * gv[1] * silu_f(ac[1])); w.y = pk2((o2 - mu) * rstd * gv[2] * silu_f(ac[2]), (o3 - mu) * rstd * gv[3] * silu_f(ac[3]));
                *(u32x2*)(ORNB + po) = w;
            }
        }
        __syncthreads();
        pg8::StaticOrder S; S.init(TP, 2048, G, blk);
        {
            Unit u_;
            for (int i_ = 0; S.next(i_, u_); ++i_) {
                const int h_ = u_.pn >> 1;
                for (int rb_ = 0; rb_ < 32; rb_ += 8) {
                    u32x4 w_[8];
#pragma unroll
                    for (int k8 = 0; k8 < 8; ++k8) w_[k8] = *(const u32x4*)(Vb + (size_t)(u_.pm * 256 + wave + 8 * (rb_ + k8)) * 2048 + h_ * 512 + lane * 8);
#pragma unroll
                    for (int k8 = 0; k8 < 8; ++k8) {
                        const int r_ = u_.pm * 256 + wave + 8 * (rb_ + k8);
                        const float a0_ = bflo(w_[k8].x), a1_ = bfhi(w_[k8].x), a2_ = bflo(w_[k8].y), a3_ = bfhi(w_[k8].y), a4_ = bflo(w_[k8].z), a5_ = bfhi(w_[k8].z), a6_ = bflo(w_[k8].w), a7_ = bfhi(w_[k8].w);
                        float s1_ = ((a0_ + a1_) + (a2_ + a3_)) + ((a4_ + a5_) + (a6_ + a7_)), s2_ = ((a0_ * a0_ + a1_ * a1_) + (a2_ * a2_ + a3_ * a3_)) + ((a4_ * a4_ + a5_ * a5_) + (a6_ * a6_ + a7_ * a7_));
                        s1_ = wave_sum(s1_); s2_ = wave_sum(s2_);
                        if (lane == 0) { STAT[(size_t)r_ * 8 + 2 * h_] = s1_; STAT[(size_t)r_ * 8 + 2 * h_ + 1] = s2_; }
                    }
                }
            }
            __threadfence_block();
        }
        __syncthreads();
        pg8::Gemm g{HN, WIN + (size_t)8192 * 1024, TP, 2048, 1024};
        EpiGR E{Vb, ORNB, STAT, g_ret_gn};
        pg8::gemm_phase<EpiGR, pg8::StaticOrder, true, true>(lds, g, S, E);
    }
#endif
    xcd_barrier(xbar); if (XBAR_TWICE) xcd_barrier(xbar);

#ifndef SKIP_P3
    for (int rep_ = 0; rep_ < REP_P3; ++rep_)
    {
        {
            PHASE_IDS(); for (int rsk_ = 0; rsk_ < REP_SK3; ++rsk_) for (int pc_ = blk; pc_ < 256; pc_ += G) { const int n0 = 16 * (pc_ >> 2), rq = pc_ & 3, g4 = lane >> 4, li = lane & 15;
            const bf16_t* HNs = HN + (size_t)TP * 1024;
            f32x4 gt = skinny_gemm(lds, HNs, 1024, WIN + (size_t)10240 * 1024, n0, rq, wave, lane), br = skinny_gemm(lds, ORNB + (size_t)TP * 2048, 2048, BRRET, n0, rq, wave, lane), mg;
#pragma unroll
            for (int i = 0; i < 4; ++i) mg[i] = sigm_f(gt[i]) * br[i];
            gt = skinny_gemm(lds, HNs, 1024, WIN + (size_t)11264 * 1024, n0, rq, wave, lane); br = skinny_gemm(lds, CB + (size_t)TP * 1024, 1024, BRCONV, n0, rq, wave, lane);
#pragma unroll
            for (int i = 0; i < 4; ++i) mg[i] += sigm_f(gt[i]) * br[i];
            gt = skinny_gemm(lds, HNs, 1024, WIN + (size_t)12288 * 1024, n0, rq, wave, lane); br = skinny_gemm(lds, MQ + (size_t)TP * 1024, 1024, BRMEM, n0, rq, wave, lane);
#pragma unroll
            for (int i = 0; i < 4; ++i) mg[i] += sigm_f(gt[i]) * br[i];
            if (wave < 4) { u32x2 w; w.x = pk2(mg[0], mg[1]); w.y = pk2(mg[2], mg[3]); *(u32x2*)(MERGED + (size_t)(TP + 64 * rq + 16 * wave + li) * 1024 + n0 + 4 * g4) = w; }
            __syncthreads(); }
        }
        pg8::StaticOrder S; S.init(TP, 1024, G, blk);
        EpiGate EG{STASH};
        { pg8::Gemm g{HN, WIN + (size_t)10240 * 1024, TP, 1024, 1024}; pg8::gemm_phase<EpiGate, pg8::StaticOrder, true, true>(lds, g, S, EG); }
        { pg8::Gemm g{ORNB, BRRET, TP, 1024, 2048}; EpiBranch<true> E{STASH, MERGED}; pg8::gemm_phase<EpiBranch<true>, pg8::StaticOrder, true, true>(lds, g, S, E); }
        { pg8::Gemm g{HN, WIN + (size_t)11264 * 1024, TP, 1024, 1024}; pg8::gemm_phase<EpiGate, pg8::StaticOrder, true, true>(lds, g, S, EG); }
        { pg8::Gemm g{CB, BRCONV, TP, 1024, 1024}; EpiBranch<false> E{STASH, MERGED}; pg8::gemm_phase<EpiBranch<false>, pg8::StaticOrder, true, true>(lds, g, S, E); }
        { pg8::Gemm g{HN, WIN + (size_t)12288 * 1024, TP, 1024, 1024}; pg8::gemm_phase<EpiGate, pg8::StaticOrder, true, true>(lds, g, S, EG); }
        { pg8::Gemm g{MQ, BRMEM, TP, 1024, 1024}; EpiBranch<false> E{STASH, MERGED}; pg8::gemm_phase<EpiBranch<false>, pg8::StaticOrder, true, true>(lds, g, S, E); }
    }
#endif
    xcd_barrier(xbar); if (XBAR_TWICE) xcd_barrier(xbar);

#ifdef PROBE_P4
    { pg8::Gemm g{MERGED, WOUT, TP, 1024, 1024}; pg8::StaticOrder S; S.init(TP, 1024, G, blk); EpiNull E{queue + 200, SS2};
      pg8::gemm_phase<EpiNull, pg8::StaticOrder, true, true>(lds, g, S, E); }
#endif
#ifndef SKIP_P4
    {
        {
            PHASE_IDS(); for (int pc_ = blk; pc_ < 256; pc_ += G) { const int n0 = 16 * (pc_ >> 2), rq = pc_ & 3, g4 = lane >> 4, li = lane & 15;
            const f32x4 ac = skinny_gemm(lds, MERGED + (size_t)TP * 1024, 1024, WOUT, n0, rq, wave, lane);
            if (wave < 4) {
                const int rs_ = 64 * rq + 16 * wave + li; const size_t off = (size_t)(TP + rs_) * 1024 + n0 + 4 * g4;
                const f32x4 v = *(const f32x4*)(x_sample + (size_t)rs_ * 1024 + n0 + 4 * g4) + ac;
                *(f32x4*)(X1 + off) = v; u32x2 w; w.x = pk2(v[0], v[1]); w.y = pk2(v[2], v[3]); *(u32x2*)(X1B + off) = w;
                float q = (v[0] * v[0] + v[1] * v[1]) + (v[2] * v[2] + v[3] * v[3]); q += __shfl_xor(q, 16); q += __shfl_xor(q, 32);
                if (g4 == 0) atomicAdd(SS1 + TP + rs_, q);
            }
            __syncthreads(); }
        }
        pg8::Gemm g{MERGED, WOUT, TP, 1024, 1024}; pg8::StaticOrder S; S.init(TP, 1024, G, blk);
        EpiRes<true> E{x_prompt, x_sample, X1, X1B, SS1};
        pg8::gemm_phase<EpiRes<true>, pg8::StaticOrder, true, true>(lds, g, S, E);
    }
#endif
    xcd_barrier(xbar); if (XBAR_TWICE) xcd_barrier(xbar);

#ifndef SKIP_P5
    for (int rep_ = 0; rep_ < REP_P5; ++rep_)
    {
        pg8::Gemm g{X1B, FFNIN, T, 5632, 1024}; pg8::StaticOrder S; S.init(T, 5632, G, blk);
        EpiUp E{ABUF, UBUF, SS1, out + O_FFNP, out + O_FFNS};
        pg8::gemm_phase<EpiUp, pg8::StaticOrder, true, true>(lds, g, S, E);
    }
#endif
    xcd_barrier(xbar); if (XBAR_TWICE) xcd_barrier(xbar);

#ifdef PROBE_P5B
    { PHASE_IDS(); const bool dz = queue[200] == 12345u;
      for (int it = blk * 512 + tid; it < 2080 * 352; it += G * 512) act_item(it, ABUF, UBUF, w_ffn_conv, state_ffn, dz); }
#endif
#ifndef SKIP_P5B
    { PHASE_IDS();
      for (int it = blk * 512 + tid; it < 2080 * 352; it += G * 512) act_item(it, ABUF, UBUF, w_ffn_conv, state_ffn); }
#endif
    xcd_barrier(xbar); if (XBAR_TWICE) xcd_barrier(xbar);

#ifdef PROBE_P6
    { pg8::Gemm g{UBUF, FFNDN, TP, 1024, DFF}; pg8::StaticOrder S; S.init(TP, 1024, G, blk); EpiNull E{queue + 200, SS1};
      pg8::gemm_phase<EpiNull, pg8::StaticOrder, true, true>(lds, g, S, E); }
#endif
#ifndef SKIP_P6
    {
        unsigned* fincnt = (unsigned*)(ws + WS_CTL + CTL_FIN);
        const bool fusedfin = (G == 256);
        {
            PHASE_IDS(); for (int pc_ = blk; pc_ < 256; pc_ += G) { const int n0 = 16 * (pc_ >> 2), rq = pc_ & 3, g4 = lane >> 4, li = lane & 15;
            const f32x4 ac = skinny_gemm(lds, UBUF + (size_t)TP * DFF, DFF, FFNDN, n0, rq, wave, lane);
            const int rs_ = 64 * rq + 16 * (wave & 3) + li; const size_t off = (size_t)(TP + rs_) * 1024 + n0 + 4 * g4;
            f32x4 v = {0.f, 0.f, 0.f, 0.f};
            if (wave < 4) {
                v = *(const f32x4*)(X1 + off) + ac;
                if (!fusedfin) *(f32x4*)(X1 + off) = v;
                float q = (v[0] * v[0] + v[1] * v[1]) + (v[2] * v[2] + v[3] * v[3]); q += __shfl_xor(q, 16); q += __shfl_xor(q, 32);
                if (g4 == 0) atomicAdd(SS2 + TP + rs_, q);
            }
            if (fusedfin) {
                panel_arrive_and_wait(fincnt + 16 * (64 + rq), 64u);
                if (wave < 4) { const float rs = rsqrtf(ld_agent_f(SS2 + TP + rs_) * (1.f / 1024.f) + EPS); *(f32x4*)(X1 + off) = v * rs * *(const f32x4*)(g_final + n0 + 4 * g4); }
            }
            __syncthreads(); }
        }
        pg8::Gemm g{UBUF, FFNDN, TP, 1024, DFF}; pg8::StaticOrder S; S.init(TP, 1024, G, blk);
        if (fusedfin) {
            EpiFinal E{X1, X1, SS2, fincnt, g_final};
            pg8::gemm_phase<EpiFinal, pg8::StaticOrder, false, true>(lds, g, S, E);
        } else {
            EpiRes<false> E{X1, X1 + (size_t)TP * 1024, X1, nullptr, SS2};
            pg8::gemm_phase<EpiRes<false>, pg8::StaticOrder, true, true>(lds, g, S, E);
        }
    }
#endif
    if (G != 256) { xcd_barrier(xbar); }

#ifdef PROBE_P7
    { PHASE_IDS(); const bool dz = queue[200] == 12345u;
    for (int m = gw; m < T; m += NGW) {
        float* row = X1 + (size_t)m * 1024; const float rs = rsqrtf(SS2[m] * (1.f / 1024.f) + EPS);
#pragma unroll
        for (int j = 0; j < 4; ++j) { f32x4 v = ((f32x4*)row)[lane + 64 * j]; const f32x4 gg = ((const f32x4*)g_final)[lane + 64 * j]; if (dz) ((f32x4*)row)[lane + 64 * j] = v * rs * gg; }
    } }
#endif
#ifndef SKIP_P7
    if (G != 256) { PHASE_IDS();
    for (int m = gw; m < T; m += NGW) {
        float* row = X1 + (size_t)m * 1024; const float rs = rsqrtf(SS2[m] * (1.f / 1024.f) + EPS);
#pragma unroll
        for (int j = 0; j < 4; ++j) { f32x4 v = ((f32x4*)row)[lane + 64 * j]; const f32x4 gg = ((const f32x4*)g_final)[lane + 64 * j]; ((f32x4*)row)[lane + 64 * j] = v * rs * gg; }
    }
    }
#endif
}

extern "C" void kernel_launch(void* const* d_in, const int* in_sizes, int n_in, void* d_out, int out_size, void* d_ws, size_t ws_size, hipStream_t stream) {
    static int grid = 0;
    if (grid == 0) {
        if (n_in != 23 || out_size != (int)O_TOTAL || ws_size < 512 * HMiB) { fprintf(stderr, "kernel_launch: unexpected shapes: n_in %d out %d ws %zu\n", n_in, out_size, ws_size); grid = -1; return; }
        int dev = 0, cus = 0, per_cu = 0;
        (void)hipGetDevice(&dev); (void)hipDeviceGetAttribute(&cus, hipDeviceAttributeMultiprocessorCount, dev);
        if (hipFuncSetAttribute((const void*)fwd_megakernel, hipFuncAttributeMaxDynamicSharedMemorySize, LDS_BYTES) != hipSuccess) { fprintf(stderr, "kernel_launch: hipFuncSetAttribute failed\n"); grid = -1; return; }
        if (hipOccupancyMaxActiveBlocksPerMultiprocessor(&per_cu, (const void*)fwd_megakernel, 512, LDS_BYTES) != hipSuccess || per_cu < 1) { fprintf(stderr, "kernel_launch: occupancy query says %d\n", per_cu); per_cu = 1; }
        (void)hipGetLastError();
        grid = cus > 0 ? cus : 256;
    }
    if (grid < 0) return;
    (void)hipMemsetAsync((char*)d_ws + WS_CTL, 0, CTL_BYTES, stream);
    Args a{};
    for (int i = 0; i < 23; ++i) a.in[i] = (const float*)d_in[i];
    a.out = (float*)d_out; a.ws = (unsigned char*)d_ws;
    void* kargs[] = {&a};
    hipError_t e = hipLaunchCooperativeKernel((const void*)fwd_megakernel, dim3(grid), dim3(512), kargs, LDS_BYTES, stream);
    if (e != hipSuccess) fprintf(stderr, "kernel_launch: cooperative launch failed: %s (grid %d)\n", hipGetErrorString(e), grid);
}
```
